# Optimizing an MI355X kernel written in HIP

```python
import jax
import jax.numpy as jnp
from jax import lax
import numpy as np


D_MODEL = 1024
BATCH = 16
SEQ = 2048
DEPTH = 2

GRID_W = 64
CTX_LEN = 256
EPS = 1e-6

ATT_HEADS = 8
ATT_KV_HEADS = 2
ATT_HEAD_DIM = 64
ATT_GROUP = ATT_HEADS // ATT_KV_HEADS
WINDOW = 128
ATT_BLOCK = 128
ROPE_BASE = 10000.0

M_HEADS = 4
M_QK_DIM = 64
M_V_DIM = 128
M_CHUNK = 64
FORGET_BIAS = 3.0

CONV_WIDTH = 512
CONV_K = 3

N_BRANCH = 3
ATT_OUT = ATT_HEADS * ATT_HEAD_DIM
M_OUT = M_HEADS * M_V_DIM

N_EXPERTS = 64
N_GROUPS = 8
TOPK_GROUPS = 4
TOP_K = 8
EXPERT_FF = 256
SHARED_FF = 256
ROUTED_SCALE = 2.5

IN_NAMES = ('q_a', 'k_a', 'v_a', 'q_m', 'k_m', 'v_m', 'o_m', 'g_m', 'b_conv', 'c_conv', 'x_conv', 'branch_gates')
IN_SIZES = (ATT_HEADS * ATT_HEAD_DIM, ATT_KV_HEADS * ATT_HEAD_DIM, ATT_KV_HEADS * ATT_HEAD_DIM,
            M_HEADS * M_QK_DIM, M_HEADS * M_QK_DIM, M_HEADS * M_V_DIM, M_HEADS * M_V_DIM, 4 * M_HEADS,
            CONV_WIDTH, CONV_WIDTH, CONV_WIDTH, N_BRANCH * D_MODEL)
D_IN = sum(IN_SIZES)

kernel_name = 'hybrid_gqa_mlstm_shortconv_moe_dit'


def rmsnorm(x, g):
    xf = x.astype(jnp.float32)
    y = xf * lax.rsqrt(jnp.mean(xf * xf, axis=-1, keepdims=True) + EPS)
    return (y * g.astype(jnp.float32)).astype(x.dtype)


def modulate(x, shift, scale):
    return x * (1 + scale) + shift


def split_proj(p):
    out = {}
    start = 0
    for name, size in zip(IN_NAMES, IN_SIZES):
        out[name] = p[..., start:start + size]
        start += size
    return out


def axial_rope(seq):
    rows = seq // GRID_W
    row = jnp.repeat(jnp.arange(rows, dtype=jnp.float32), GRID_W)
    col = jnp.tile(jnp.arange(GRID_W, dtype=jnp.float32), rows)
    n_pairs = ATT_HEAD_DIM // 4
    inv_freq = ROPE_BASE ** (-jnp.arange(n_pairs, dtype=jnp.float32) / n_pairs)
    ang = jnp.concatenate([row[:, None] * inv_freq, col[:, None] * inv_freq], axis=-1)
    return jnp.cos(ang), jnp.sin(ang)


def apply_rope(x, cos, sin):
    xf = x.astype(jnp.float32).reshape(*x.shape[:-1], -1, 2)
    c = cos[None, :, None, :]
    s = sin[None, :, None, :]
    x0 = xf[..., 0]
    x1 = xf[..., 1]
    out = jnp.stack([x0 * c - x1 * s, x0 * s + x1 * c], axis=-1)
    return out.reshape(x.shape).astype(x.dtype)


def latent_window_attention(q, k, v, kc, vc, sink):
    B, S = q.shape[:2]
    LC = kc.shape[1]
    nb = S // ATT_BLOCK
    scale = ATT_HEAD_DIM ** -0.5
    pad = ((0, 0), (ATT_BLOCK, ATT_BLOCK), (0, 0), (0, 0))
    kp = jnp.pad(k, pad)
    vp = jnp.pad(v, pad)
    sink_l = sink.astype(jnp.float32).reshape(ATT_KV_HEADS, ATT_GROUP)[None, :, :, None, None]

    def block(j):
        q0 = j * ATT_BLOCK
        qj = lax.dynamic_slice_in_dim(q, q0, ATT_BLOCK, axis=1)
        qj = qj.reshape(B, ATT_BLOCK, ATT_KV_HEADS, ATT_GROUP, ATT_HEAD_DIM)
        kj = lax.dynamic_slice_in_dim(kp, q0, 3 * ATT_BLOCK, axis=1)
        vj = lax.dynamic_slice_in_dim(vp, q0, 3 * ATT_BLOCK, axis=1)
        qpos = q0 + jnp.arange(ATT_BLOCK)
        kpos = q0 - ATT_BLOCK + jnp.arange(3 * ATT_BLOCK)
        valid = ((jnp.abs(kpos[None, :] - qpos[:, None]) <= WINDOW)
                 & (kpos >= 0)[None, :] & (kpos < S)[None, :])
        s_band = jnp.einsum('bqhgd,bphd->bhgqp', qj, kj, preferred_element_type=jnp.float32) * scale
        s_band = jnp.where(valid, s_band, -jnp.inf)
        s_ctx = jnp.einsum('bqhgd,bchd->bhgqc', qj, kc, preferred_element_type=jnp.float32) * scale
        s_sink = jnp.broadcast_to(sink_l, s_ctx.shape[:-1] + (1,))
        probs = jax.nn.softmax(jnp.concatenate([s_sink, s_ctx, s_band], axis=-1), axis=-1).astype(v.dtype)
        o = (jnp.einsum('bhgqc,bchd->bqhgd', probs[..., 1:1 + LC], vc)
             + jnp.einsum('bhgqp,bphd->bqhgd', probs[..., 1 + LC:], vj))
        return o.reshape(B, ATT_BLOCK, ATT_OUT)

    out = lax.map(block, jnp.arange(nb))
    return out.transpose(1, 0, 2, 3).reshape(B, S, ATT_OUT)


def context_attention(qc, kc, vc, sink):
    B, L = qc.shape[:2]
    scale = ATT_HEAD_DIM ** -0.5
    qg = qc.reshape(B, L, ATT_KV_HEADS, ATT_GROUP, ATT_HEAD_DIM)
    s = jnp.einsum('bqhgd,bchd->bhgqc', qg, kc, preferred_element_type=jnp.float32) * scale
    sink_l = sink.astype(jnp.float32).reshape(ATT_KV_HEADS, ATT_GROUP)[None, :, :, None, None]
    s_sink = jnp.broadcast_to(sink_l, s.shape[:-1] + (1,))
    probs = jax.nn.softmax(jnp.concatenate([s_sink, s], axis=-1), axis=-1).astype(vc.dtype)
    o = jnp.einsum('bhgqc,bchd->bqhgd', probs[..., 1:], vc)
    return o.reshape(B, L, ATT_OUT)


def mlstm_zero_state(batch):
    return (jnp.zeros((batch, M_HEADS, M_V_DIM, M_QK_DIM), jnp.float32),
            jnp.zeros((batch, M_HEADS, M_QK_DIM), jnp.float32),
            jnp.zeros((batch, M_HEADS), jnp.float32))


def mlstm_scan(q, k, v, ig, lf, state):
    B, L = q.shape[:2]
    nc = L // M_CHUNK
    causal = jnp.tril(jnp.ones((M_CHUNK, M_CHUNK), dtype=bool))

    def to_chunks(a):
        return jnp.moveaxis(a.reshape(B, nc, M_CHUNK, *a.shape[2:]), 1, 0)

    def step(carry, xs):
        C, n, m = carry
        qc, kc, vc, igc, lfc = xs
        b = jnp.cumsum(lfc, axis=1)
        a_inter = b + m[:, None, :]
        dmat = b[:, :, None, :] - b[:, None, :, :] + igc[:, None, :, :]
        dmat = jnp.where(causal[None, :, :, None], dmat, -jnp.inf)
        m_s = jnp.maximum(a_inter, jnp.max(dmat, axis=2))
        w_inter = jnp.exp(a_inter - m_s)
        w_intra = jnp.exp(dmat - m_s[:, :, None, :])
        s_qk = w_intra * jnp.einsum('bshd,brhd->bsrh', qc, kc)
        num = jnp.einsum('bsrh,brhe->bshe', s_qk, vc) + w_inter[..., None] * jnp.einsum('bhed,bshd->bshe', C, qc)
        den = jnp.sum(s_qk, axis=2) + w_inter * jnp.einsum('bhd,bshd->bsh', n, qc)
        h = num / jnp.maximum(jnp.abs(den), jnp.exp(-m_s))[..., None]
        b_last = b[:, -1, :]
        m_new = jnp.maximum(b_last + m, jnp.max(b_last[:, None, :] - b + igc, axis=1))
        decay = jnp.exp(b_last + m - m_new)
        w_r = jnp.exp(b_last[:, None, :] - b + igc - m_new[:, None, :])
        C_new = decay[..., None, None] * C + jnp.einsum('brh,brhe,brhd->bhed', w_r, vc, kc)
        n_new = decay[..., None] * n + jnp.einsum('brh,brhd->bhd', w_r, kc)
        return (C_new, n_new, m_new), h

    state, h = lax.scan(step, state, (to_chunks(q), to_chunks(k), to_chunks(v), to_chunks(ig), to_chunks(lf)))
    return jnp.moveaxis(h, 0, 1).reshape(B, L, M_HEADS, M_V_DIM), state


def mlstm_inputs(p, gate_b):
    B, L = p['q_m'].shape[:2]
    f32 = jnp.float32
    q = p['q_m'].reshape(B, L, M_HEADS, M_QK_DIM).astype(f32)
    k = p['k_m'].reshape(B, L, M_HEADS, M_QK_DIM).astype(f32) * (M_QK_DIM ** -0.5)
    v = p['v_m'].reshape(B, L, M_HEADS, M_V_DIM).astype(f32)
    g = p['g_m'].reshape(B, L, 4, M_HEADS).astype(f32) + gate_b.astype(f32)
    gates_fwd = (g[:, :, 0], jax.nn.log_sigmoid(g[:, :, 1]))
    gates_bwd = (g[:, :, 2], jax.nn.log_sigmoid(g[:, :, 3]))
    return q, k, v, gates_fwd, gates_bwd


def mlstm_bidir(q, k, v, gates_fwd, gates_bwd, state_fwd, state_bwd):
    h_f, st_f = mlstm_scan(q, k, v, gates_fwd[0], gates_fwd[1], state_fwd)
    flip = lambda a: jnp.flip(a, axis=1)
    h_b, st_b = mlstm_scan(flip(q), flip(k), flip(v), flip(gates_bwd[0]), flip(gates_bwd[1]), state_bwd)
    return h_f + flip(h_b), st_f, st_b


def mlstm_output(h, o_pre, norm_g):
    B, L = h.shape[:2]
    hn = h * lax.rsqrt(jnp.mean(h * h, axis=-1, keepdims=True) + EPS)
    hn = hn * norm_g.astype(jnp.float32).reshape(M_HEADS, M_V_DIM)
    out = jax.nn.sigmoid(o_pre.astype(jnp.float32)) * hn.reshape(B, L, M_OUT)
    return out.astype(o_pre.dtype)


def short_conv_mixer(p, conv_w):
    u = p['c_conv'] * p['x_conv']
    w = conv_w.astype(u.dtype)[:, None, :]
    y = lax.conv_general_dilated(u, w, window_strides=(1,), padding=((CONV_K // 2, CONV_K // 2),),
                                 dimension_numbers=('NWC', 'WIO', 'NWC'), feature_group_count=CONV_WIDTH)
    return p['b_conv'] * y


def merge_branches(y_att, y_mls, y_conv, gate_pre, lp):
    g = jax.nn.sigmoid(gate_pre + lp['branch_gate_b'].reshape(-1))
    g = g.reshape(*gate_pre.shape[:-1], N_BRANCH, D_MODEL)
    y = (g[..., 0, :] * (y_att @ lp['w_br_attn'])
         + g[..., 1, :] * (y_mls @ lp['w_br_mlstm'])
         + g[..., 2, :] * (y_conv @ lp['w_br_conv']))
    return y @ lp['w_out']


def token_mixers(h, hc, lp, cos, sin, need_ctx):
    B, S = h.shape[:2]
    L = hc.shape[1]
    p = split_proj(h @ lp['w_in'])
    pc = split_proj(hc @ lp['w_in'])
    q = apply_rope(p['q_a'].reshape(B, S, ATT_HEADS, ATT_HEAD_DIM), cos, sin)
    k = apply_rope(p['k_a'].reshape(B, S, ATT_KV_HEADS, ATT_HEAD_DIM), cos, sin)
    v = p['v_a'].reshape(B, S, ATT_KV_HEADS, ATT_HEAD_DIM)
    kc = pc['k_a'].reshape(B, L, ATT_KV_HEADS, ATT_HEAD_DIM)
    vc = pc['v_a'].reshape(B, L, ATT_KV_HEADS, ATT_HEAD_DIM)
    y_att = latent_window_attention(q, k, v, kc, vc, lp['attn_sink'])
    qm_c, km_c, vm_c, gf_c, gb_c = mlstm_inputs(pc, lp['mlstm_gate_b'])
    zero = mlstm_zero_state(B)
    hm_c, st_f, st_b = mlstm_bidir(qm_c, km_c, vm_c, gf_c, gb_c, zero, zero)
    qm, km, vm, gf, gb = mlstm_inputs(p, lp['mlstm_gate_b'])
    hm, _, _ = mlstm_bidir(qm, km, vm, gf, gb, st_f, st_b)
    y_mls = mlstm_output(hm, p['o_m'], lp['mlstm_norm_g'])
    y_conv = short_conv_mixer(p, lp['conv_w'])
    y = merge_branches(y_att, y_mls, y_conv, p['branch_gates'], lp)
    if not need_ctx:
        return y, None
    qc = pc['q_a'].reshape(B, L, ATT_HEADS, ATT_HEAD_DIM)
    yc_att = context_attention(qc, kc, vc, lp['attn_sink'])
    yc_mls = mlstm_output(hm_c, pc['o_m'], lp['mlstm_norm_g'])
    yc_conv = short_conv_mixer(pc, lp['conv_w'])
    yc = merge_branches(yc_att, yc_mls, yc_conv, pc['branch_gates'], lp)
    return y, yc


def swiglu(t, wg, wu, wd):
    return (jax.nn.silu(t @ wg) * (t @ wu)) @ wd


def moe(h, router_w, router_bias, exp_w_gate, exp_w_up, exp_w_down, sh_w_gate, sh_w_up, sh_w_down):
    shape = h.shape
    t = h.reshape(-1, D_MODEL)
    T = t.shape[0]
    scores = jax.nn.sigmoid((t @ router_w).astype(jnp.float32))
    sel = scores + router_bias.astype(jnp.float32)
    grp = sel.reshape(T, N_GROUPS, N_EXPERTS // N_GROUPS)
    grp_score = jnp.sum(lax.top_k(grp, 2)[0], axis=-1)
    _, gidx = lax.top_k(grp_score, TOPK_GROUPS)
    gmask = jnp.sum(jax.nn.one_hot(gidx, N_GROUPS, dtype=jnp.float32), axis=-2) > 0
    emask = jnp.repeat(gmask, N_EXPERTS // N_GROUPS, axis=-1)
    _, eidx = lax.top_k(jnp.where(emask, sel, -jnp.inf), TOP_K)
    w = jnp.take_along_axis(scores, eidx, axis=-1)
    w = w / jnp.sum(w, axis=-1, keepdims=True) * ROUTED_SCALE
    gates = jnp.sum(jax.nn.one_hot(eidx, N_EXPERTS, dtype=jnp.float32) * w[..., None], axis=-2)
    shared = swiglu(t, sh_w_gate, sh_w_up, sh_w_down)

    def body(acc, xs):
        wg, wu, wd, ge = xs
        return acc + ge[:, None] * swiglu(t, wg, wu, wd), None

    routed, _ = lax.scan(body, jnp.zeros_like(t), (exp_w_gate, exp_w_up, exp_w_down, gates.T.astype(t.dtype)))
    return (shared + routed).reshape(shape)


def setup_inputs(seed: int = 0) -> dict:
    key = jax.random.key(seed)
    keys = list(jax.random.split(key, 32))
    D = D_MODEL

    def nrm(shape, s):
        return jax.random.normal(keys.pop(), shape, jnp.float32) * s

    return {
        'x': nrm((BATCH, SEQ, D), 1.0),
        'c': nrm((BATCH, D), 1.0),
        'ctx': nrm((BATCH, CTX_LEN, D), 1.0),
        'c_ctx': nrm((D,), 1.0),
        'ada_w': nrm((DEPTH, D, 6 * D), 0.5 * D ** -0.5),
        'ada_b': nrm((DEPTH, 6 * D), 0.02),
        'norm1_g': 1.0 + nrm((DEPTH, D), 0.02),
        'norm2_g': 1.0 + nrm((DEPTH, D), 0.02),
        'w_in': nrm((DEPTH, D, D_IN), D ** -0.5),
        'attn_sink': nrm((DEPTH, ATT_HEADS), 0.5),
        'mlstm_gate_b': nrm((DEPTH, 4, M_HEADS), 0.1) + jnp.array([0.0, FORGET_BIAS, 0.0, FORGET_BIAS], jnp.float32)[None, :, None],
        'mlstm_norm_g': 1.0 + nrm((DEPTH, M_OUT), 0.02),
        'conv_w': nrm((DEPTH, CONV_K, CONV_WIDTH), CONV_K ** -0.5),
        'w_br_attn': nrm((DEPTH, ATT_OUT, D), ATT_OUT ** -0.5),
        'w_br_mlstm': nrm((DEPTH, M_OUT, D), M_OUT ** -0.5),
        'w_br_conv': nrm((DEPTH, CONV_WIDTH, D), CONV_WIDTH ** -0.5),
        'branch_gate_b': nrm((DEPTH, N_BRANCH, D), 0.02),
        'w_out': nrm((DEPTH, D, D), D ** -0.5),
        'router_w': nrm((DEPTH, D, N_EXPERTS), D ** -0.5),
        'router_bias': nrm((DEPTH, N_EXPERTS), 0.01),
        'exp_w_gate': nrm((DEPTH, N_EXPERTS, D, EXPERT_FF), D ** -0.5),
        'exp_w_up': nrm((DEPTH, N_EXPERTS, D, EXPERT_FF), D ** -0.5),
        'exp_w_down': nrm((DEPTH, N_EXPERTS, EXPERT_FF, D), EXPERT_FF ** -0.5),
        'sh_w_gate': nrm((DEPTH, D, SHARED_FF), D ** -0.5),
        'sh_w_up': nrm((DEPTH, D, SHARED_FF), D ** -0.5),
        'sh_w_down': nrm((DEPTH, SHARED_FF, D), SHARED_FF ** -0.5),
        'final_g': 1.0 + nrm((D,), 0.02),
    }


def reference(x, c, ctx, c_ctx, ada_w, ada_b, norm1_g, norm2_g, w_in, attn_sink, mlstm_gate_b,
              mlstm_norm_g, conv_w, w_br_attn, w_br_mlstm, w_br_conv, branch_gate_b, w_out,
              router_w, router_bias, exp_w_gate, exp_w_up, exp_w_down, sh_w_gate, sh_w_up,
              sh_w_down, final_g):
    seq = x.shape[1]
    cos, sin = axial_rope(seq)
    xc = ctx
    s_lat = jax.nn.silu(c)
    s_ctx = jax.nn.silu(c_ctx)
    for l in range(DEPTH):
        need_ctx = l < DEPTH - 1
        mod = (s_lat @ ada_w[l] + ada_b[l])[:, None, :]
        modc = s_ctx @ ada_w[l] + ada_b[l]
        sh1, sc1, g1, sh2, sc2, g2 = jnp.split(mod, 6, axis=-1)
        csh1, csc1, cg1, csh2, csc2, cg2 = jnp.split(modc, 6, axis=-1)
        lp = {
            'w_in': w_in[l], 'attn_sink': attn_sink[l], 'mlstm_gate_b': mlstm_gate_b[l],
            'mlstm_norm_g': mlstm_norm_g[l], 'conv_w': conv_w[l], 'w_br_attn': w_br_attn[l],
            'w_br_mlstm': w_br_mlstm[l], 'w_br_conv': w_br_conv[l], 'branch_gate_b': branch_gate_b[l],
            'w_out': w_out[l],
        }
        h = modulate(rmsnorm(x, norm1_g[l]), sh1, sc1)
        hc = modulate(rmsnorm(xc, norm1_g[l]), csh1, csc1)
        y, yc = token_mixers(h, hc, lp, cos, sin, need_ctx)
        x = x + g1 * y
        h = modulate(rmsnorm(x, norm2_g[l]), sh2, sc2)
        x = x + g2 * moe(h, router_w[l], router_bias[l], exp_w_gate[l], exp_w_up[l], exp_w_down[l],
                         sh_w_gate[l], sh_w_up[l], sh_w_down[l])
        if need_ctx:
            xc = xc + cg1 * yc
            hc = modulate(rmsnorm(xc, norm2_g[l]), csh2, csc2)
            xc = xc + cg2 * moe(hc, router_w[l], router_bias[l], exp_w_gate[l], exp_w_up[l], exp_w_down[l],
                                sh_w_gate[l], sh_w_up[l], sh_w_down[l])
    return rmsnorm(x, final_g)
```

```cpp
#include <hip/hip_runtime.h>
#include <cstdio>
#include <cstdint>

#ifndef DUP
#define DUP -99
#endif
#ifndef FP8_MOE2_MASK
#define FP8_MOE2_MASK 3
#endif
#define FP8_MOE2_L(l) (((FP8_MOE2_MASK) >> (l)) & 1)
#ifndef FP8_MRG_MASK
#define FP8_MRG_MASK 2
#endif
#define FP8_MRG_L(l) (((FP8_MRG_MASK) >> (l)) & 1)
#ifndef FP8_WIN_MASK
#define FP8_WIN_MASK 2
#endif
#define FP8_WIN_L(l) (((FP8_WIN_MASK) >> (l)) & 1)
#ifndef FP8_MOE1
#define FP8_MOE1 1
#endif
#ifndef YP8
#define YP8 1
#endif
#ifndef MK_ONE_LAUNCH
#define MK_ONE_LAUNCH 1
#endif
#ifndef USE_MFMA_WIN
#define USE_MFMA_WIN 1
#endif
#ifndef USE_MFMA_WOUT
#define USE_MFMA_WOUT 1
#endif
#ifndef USE_MFMA_MOE
#define USE_MFMA_MOE 1
#endif
#ifndef USE_MFMA_MERGE
#define USE_MFMA_MERGE 1
#endif
#ifndef USE_MFMA_MLSTM
#define USE_MFMA_MLSTM 1
#endif
#ifndef USE_MFMA_ATTN
#define USE_MFMA_ATTN 1
#endif

#define GAS __attribute__((address_space(1)))
#define LAS __attribute__((address_space(3)))
typedef unsigned short bf16;
typedef unsigned u32x4 __attribute__((ext_vector_type(4)));
typedef unsigned u32x2 __attribute__((ext_vector_type(2)));
typedef float f32x4 __attribute__((ext_vector_type(4)));
typedef short bf16x8 __attribute__((ext_vector_type(8)));

constexpr int D = 1024, BATCH = 16, SEQ = 2048, CTXL = 256, DEPTH = 2, DIN = 6928, PSTR = 7168;
constexpr int NG = 4, GB = BATCH / NG, RL = GB * SEQ, RC = GB * CTXL, R = RL + RC;
constexpr int OQA = 0, OKA = 512, OVA = 640, OQM = 768, OKM = 1024, OVM = 1280, OOM = 1792, OGM = 2304, OBC = 2320, OCC = 2832, OXC = 3344, OBG = 3856;
constexpr int NE = 64, TOPK = 8, EFF = 256;
constexpr float WBR_SCALE = 16.0f, YM_SCALE = 8.0f, WOUT_SCALE = 32.0f;
constexpr float H_SCALE = 16.0f, W2_SCALE = 16.0f;
constexpr float YP_SCALE = 64.0f;
constexpr float WIN_SCALE = 32.0f;
constexpr int YCS = 1536;
constexpr int MAXT = (R * TOPK) / 256 + NE;
constexpr int NPMAX = MAXT * 256;
constexpr float EPS = 1e-6f;
constexpr int NTHR = 512, NWAVES = 8;

constexpr size_t MiB = 1u << 20;
constexpr size_t WS_CTL = 0, CTL_ZERO_BYTES = 1 * MiB;
constexpr size_t WS_MOD = 1 * MiB;
constexpr size_t WS_ROPE = 2 * MiB;
constexpr size_t WS_ROUTE = 3 * MiB;
constexpr size_t WS_X = 6 * MiB;
constexpr size_t WS_A = WS_X + 36 * MiB;
constexpr size_t WS_P = WS_A + 18 * MiB;
constexpr size_t WS_YATT = WS_P + 126 * MiB;
constexpr size_t WS_YMLS = WS_YATT + 9 * MiB;
constexpr size_t WS_YCONV = WS_YMLS + 9 * MiB;
constexpr size_t WS_HDIR = WS_YCONV + 9 * MiB;
constexpr size_t WS_YP = WS_P;
constexpr size_t WS_YMERGE = 256 * MiB;
constexpr size_t WS_H = WS_YMERGE + 18 * MiB;
constexpr size_t WS_YS = WS_H;
constexpr size_t WS_WB = WS_H + 49 * MiB;
constexpr size_t WB_WIN = 0, WB_WOUT = 14 * MiB, WB_WBR = 16 * MiB, WB_W1 = 19 * MiB, WB_W2 = 84 * MiB, WB_LAYER = 117 * MiB;
constexpr size_t WS_CIN = WS_WB + 2 * WB_LAYER;
constexpr size_t WS_A8 = WS_CIN + 18 * MiB;
constexpr size_t WS_END = WS_A8 + 9 * MiB;
static_assert(WS_P + (size_t)(NPMAX + R) * 1024 * 2 <= WS_YMERGE, "Yp overlay");
static_assert((size_t)(NPMAX + R) * 256 * 2 <= 49 * MiB, "H");
static_assert((size_t)65 * 512 * 1024 * 2 <= WB_W2 - WB_W1 && WB_W2 + (size_t)65 * 1024 * 256 * 2 <= WB_LAYER, "weights");
constexpr int CW_BAR = 4096;
constexpr int CW_CNT = 16384;
constexpr size_t RT_EIDX = 0, RT_EW = RT_EIDX + (size_t)R * 8 * 4, RT_SPOS = RT_EW + (size_t)R * 8 * 4, RT_ROWTOK = RT_SPOS + (size_t)R * 8 * 4,
                 RT_ROWW = RT_ROWTOK + (size_t)(NPMAX + R) * 4, RT_TILEE = RT_ROWW + (size_t)(NPMAX + R) * 4, RT_NT = RT_TILEE + 512 * 4, RT_END = RT_NT + 256;
static_assert(RT_END <= 3 * MiB, "route tables");

constexpr int LDS_BYTES = 147456;

typedef GAS unsigned gu32;
#define RLX_AGENT __ATOMIC_RELAXED, __HIP_MEMORY_SCOPE_AGENT
__device__ __forceinline__ float bf2f(unsigned short b) { return __uint_as_float(((unsigned)b) << 16); }
__device__ __forceinline__ unsigned f2bf(float f) { unsigned u = __float_as_uint(f); return (u + 0x7fffu + ((u >> 16) & 1u)) >> 16; }
__device__ __forceinline__ unsigned pk2(float lo, float hi) { return f2bf(lo) | (f2bf(hi) << 16); }
__device__ __forceinline__ float blo(unsigned w) { return __uint_as_float(w << 16); }
__device__ __forceinline__ float bhi(unsigned w) { return __uint_as_float(w & 0xffff0000u); }
__device__ __forceinline__ float clamp_e4m3(float x) { return __builtin_amdgcn_fmed3f(x, -448.0f, 448.0f); }
__device__ __forceinline__ unsigned pk4_fp8(float a, float b, float c, float d) {
    unsigned w = __builtin_amdgcn_cvt_pk_fp8_f32(clamp_e4m3(a), clamp_e4m3(b), 0u, false); return __builtin_amdgcn_cvt_pk_fp8_f32(clamp_e4m3(c), clamp_e4m3(d), w, true); }
__device__ __forceinline__ float sigmoidf_(float x) { return 1.0f / (1.0f + __expf(-x)); }
template <int CTRL, int ROWMASK> __device__ __forceinline__ float dpp_f(float old, float v) {
    return __int_as_float(__builtin_amdgcn_update_dpp(__float_as_int(old), __float_as_int(v), CTRL, ROWMASK, 0xF, false)); }
__device__ __forceinline__ float wave_sum(float v) {
    v += dpp_f<0xB1, 0xF>(0.f, v); v += dpp_f<0x4E, 0xF>(0.f, v); v += dpp_f<0x141, 0xF>(0.f, v); v += dpp_f<0x140, 0xF>(0.f, v);
    v += dpp_f<0x142, 0xA>(0.f, v); v += dpp_f<0x143, 0xC>(0.f, v);
    return __int_as_float(__builtin_amdgcn_readlane(__float_as_int(v), 63));
}
__device__ __forceinline__ float wave_max(float v) {
    v = fmaxf(v, dpp_f<0xB1, 0xF>(v, v)); v = fmaxf(v, dpp_f<0x4E, 0xF>(v, v)); v = fmaxf(v, dpp_f<0x141, 0xF>(v, v)); v = fmaxf(v, dpp_f<0x140, 0xF>(v, v));
    v = fmaxf(v, dpp_f<0x142, 0xA>(v, v)); v = fmaxf(v, dpp_f<0x143, 0xC>(v, v));
    return __int_as_float(__builtin_amdgcn_readlane(__float_as_int(v), 63));
}
__device__ __forceinline__ float oct_max(float v) {
    v = fmaxf(v, dpp_f<0xB1, 0xF>(v, v)); v = fmaxf(v, dpp_f<0x4E, 0xF>(v, v)); return fmaxf(v, dpp_f<0x141, 0xF>(v, v)); }

#define XB_TMO      128
#define XB_XCNT(j)  (256  + 64 * (j))
#define XB_XSUB(j)  (1280 + 64 * (j))
#define XB_XGEN(j)  (2304 + 64 * (j))
#define XB_TOP      3328
#define XB_TOPGEN   3392
#define XCD_BAR_WORDS 3456
#define XB_SPIN_CAP (1u << 22)
__device__ __forceinline__ unsigned xb_ld(unsigned* p)              { return __hip_atomic_load(p, __ATOMIC_RELAXED, __HIP_MEMORY_SCOPE_AGENT); }
__device__ __forceinline__ unsigned xb_add(unsigned* p, unsigned v) { return __hip_atomic_fetch_add(p, v, __ATOMIC_RELAXED, __HIP_MEMORY_SCOPE_AGENT); }
__device__ __forceinline__ unsigned xb_xcc_id() { return (unsigned)__builtin_amdgcn_s_getreg((3 << 11) | 20) & 0xFu; }
#define XB_SPIN(cond, bar) do { unsigned _sp = 0; while (cond) { __builtin_amdgcn_s_sleep(1); \
    if ((++_sp & 255u) == 0u) { if (xb_ld(&(bar)[XB_TMO])) break; if (_sp > XB_SPIN_CAP) { atomicAdd(&(bar)[XB_TMO], 1u); break; } } } } while (0)
struct XcdBarrier { unsigned* bar; unsigned x; volatile LAS unsigned* st; };
__device__ __forceinline__ XcdBarrier xcd_barrier_post(unsigned* bar, volatile LAS unsigned* st) {
    XcdBarrier b; b.bar = bar; b.x = xb_xcc_id(); b.st = st;
    if (threadIdx.x == 0) (void)xb_add(&bar[XB_XCNT(b.x)], 1u);
    return b;
}
__device__ __forceinline__ void xcd_barrier_complete(unsigned* bar, unsigned x, unsigned& nloc, unsigned& nx) {
    const unsigned G = gridDim.x * gridDim.y * gridDim.z;
    unsigned sum, cnt, mine, sp = 0u;
    for (;;) {
        sum = 0u; cnt = 0u; mine = 0u;
#pragma unroll
        for (unsigned j = 0; j < 16; ++j) { const unsigned c = xb_ld(&bar[XB_XCNT(j)]); sum += c; cnt += (c > 0u) ? 1u : 0u; mine = (j == x) ? c : mine; }
        if (sum == G) break;
        __builtin_amdgcn_s_sleep(1);
        if ((++sp & 255u) == 0u) { if (xb_ld(&bar[XB_TMO])) break; if (sp > XB_SPIN_CAP) { atomicAdd(&bar[XB_TMO], 1u); break; } }
    }
    nloc = mine > 0u ? mine : 1u; nx = cnt > 0u ? cnt : 1u;
}
__device__ __forceinline__ void xcd_barrier(const XcdBarrier& b) {
    asm volatile("s_waitcnt vmcnt(0)" ::: "memory");
    __syncthreads();
    if (threadIdx.x == 0) {
        unsigned* bar = b.bar;
        __builtin_amdgcn_s_waitcnt(0);
        unsigned nloc = b.st[0], nx = b.st[1];
        if (nloc == 0u) { xcd_barrier_complete(bar, b.x, nloc, nx); b.st[0] = nloc; b.st[1] = nx; }
        const unsigned old = xb_add(&bar[XB_XSUB(b.x)], 1u);
        const unsigned gen = old / nloc;
        if (old + 1u == (gen + 1u) * nloc) {
            __builtin_amdgcn_fence(__ATOMIC_RELEASE, "agent");
            asm volatile("s_waitcnt vmcnt(0)" ::: "memory");
            const unsigned og = xb_add(&bar[XB_TOP], 1u);
            const unsigned tg = og / nx;
            if (og + 1u == (tg + 1u) * nx) xb_add(&bar[XB_TOPGEN], 1u);
            else XB_SPIN(xb_ld(&bar[XB_TOPGEN]) == tg, bar);
            __builtin_amdgcn_fence(__ATOMIC_ACQUIRE, "agent");
            xb_add(&bar[XB_XGEN(b.x)], 1u);
            asm volatile("s_waitcnt vmcnt(0)" ::: "memory");
        } else {
            XB_SPIN(xb_ld(&bar[XB_XGEN(b.x)]) == gen, bar);
            __builtin_amdgcn_fence(__ATOMIC_ACQUIRE, "agent");
            asm volatile("s_waitcnt vmcnt(0)" ::: "memory");
        }
    }
    __syncthreads();
}

namespace pg8 {
constexpr int BM = 256, BK = 64, HALF = 128, HTB = HALF * BK * 2, STAGE_BYTES = 8 * HTB, NXCD = 8, WGM = 8;
constexpr int IDX_OFF = STAGE_BYTES, TILEE_OFF = STAGE_BYTES + 2048;
__device__ __forceinline__ int lds_byte(int r, int c) { const int st = (r >> 4) * 2 + (c >> 5), rr = r & 15, cc = c & 31, ob = rr * 64 + cc * 2; return st * 1024 + (ob ^ (((ob >> 9) & 1) << 5)); }
__device__ __forceinline__ void stage_rc(int b, int& R_, int& C_) { const int st = b / 1024, sb = b % 1024, swz = sb ^ (((sb >> 9) & 1) << 5); R_ = (st >> 1) * 16 + swz / 64; C_ = (st & 1) * 32 + (swz % 64) / 2; }
__device__ __forceinline__ int perm32(int rho) { const int n = rho >> 4, i = rho & 15; return 8 * (i >> 2) + 4 * n + (i & 3); }
__device__ __forceinline__ unsigned cvt_pk_bf16(float lo, float hi) { unsigned r; asm volatile("v_cvt_pk_bf16_f32 %0, %1, %2" : "=v"(r) : "v"(lo), "v"(hi)); return r; }
struct Unit { int pm, pn, pb, kofs; };
__device__ __forceinline__ int xcd_chunk(int L, int nwg) { const int q = nwg / NXCD, r = nwg % NXCD, xcd = L % NXCD, off = L / NXCD; return (xcd < r ? xcd * (q + 1) : r * (q + 1) + (xcd - r) * q) + off; }
struct DenseSched {
    static constexpr bool GATHER = false;
    int nM, nN, nwg, G, c;
    __device__ __forceinline__ void init(int nM_, int nN_, int G_, int c_) { nM = nM_; nN = nN_; nwg = nM * nN; G = G_; c = c_; }
    __device__ __forceinline__ bool next(int i, Unit& u) const {
        const long L = (long)i * G + c; if (L >= nwg) return false;
        const int wgid = xcd_chunk((int)L, nwg);
        const int nig = WGM * nN, gid = wgid / nig, fm = gid * WGM, gsz = (nM - fm) < WGM ? (nM - fm) : WGM;
        u.pm = fm + ((wgid % nig) % gsz); u.pn = (wgid % nig) / gsz; u.pb = u.pn; u.kofs = 0; return true;
    }
    __device__ __forceinline__ const int* idx_ptr(const Unit&) const { return nullptr; }
};
struct MergeSched {
    static constexpr bool GATHER = false;
    int nM, nN, nwg, G, c;
    __device__ __forceinline__ void init(int nM_, int nN_, int G_, int c_) { nM = nM_; nN = nN_; nwg = nM * nN; G = G_; c = c_; }
    __device__ __forceinline__ bool next(int i, Unit& u) const {
        const int q = i / 3, sg = i - 3 * q;
        const long L = (long)q * G + c; if (L >= nwg) return false;
        const int wgid = xcd_chunk((int)L, nwg);
        const int nig = WGM * nN, gid = wgid / nig, fm = gid * WGM, gsz = (nM - fm) < WGM ? (nM - fm) : WGM;
        u.pm = fm + ((wgid % nig) % gsz); u.pn = (wgid % nig) / gsz; u.pb = u.pn; u.kofs = sg * 512; return true;
    }
    __device__ __forceinline__ const int* idx_ptr(const Unit&) const { return nullptr; }
};
template <int NPN, bool GATHER_> struct MoeSched {
    static constexpr bool GATHER = GATHER_;
    int nwg, G, c, base, stride; const LAS int* tilee; const int* rowtok;
    __device__ __forceinline__ void init(int ntile, int G_, int c_, const LAS int* te, const int* rt) {
        nwg = ntile * NPN; G = G_; c = c_; tilee = te; rowtok = rt;
        if ((G & 7) == 0) { const int q = nwg / NXCD, r = nwg % NXCD, xcd = c & 7; base = (xcd < r ? xcd * (q + 1) : r * (q + 1) + (xcd - r) * q) + (c >> 3); stride = G >> 3; }
        else { base = c; stride = G; }
    }
    __device__ __forceinline__ bool next(int i, Unit& u) const {
        if (i * G + c >= nwg) return false;
        const int wgid = base + i * stride;
        u.pm = wgid / NPN; u.pn = wgid % NPN; u.pb = __builtin_amdgcn_readfirstlane(tilee[u.pm]) * NPN + u.pn; u.kofs = 0; return true;
    }
    __device__ __forceinline__ const int* idx_ptr(const Unit& u) const { return rowtok + (size_t)u.pm * 256; }
};

typedef int i32x8 __attribute__((ext_vector_type(8)));
template <class Epi, class Sched, int ES = 2>
__device__ __forceinline__ void gemm_run(LAS unsigned char* lds, const int tid  , const void* Ab, const void* Btb, const int K  , const int lda, const int ldb  , const Sched& S, const Epi& E) {
    const int wid = __builtin_amdgcn_readfirstlane(tid >> 6), lane = tid & 63, wr = wid >> 2, wc = wid & 3, fr = lane & 15, fq = lane >> 4;
    int nt = (K * ES) / (BK * 2); asm volatile("" : "+s"(nt));
    unsigned voffB[2];
#pragma unroll
    for (int i = 0; i < 2; ++i) { int R_, C_; stage_rc(tid * 16 + i * 8192, R_, C_);
        const int Rb = Epi::PERM ? ((R_ & ~31) + perm32(R_ & 31)) : R_; voffB[i] = (unsigned)Rb * (unsigned)(ldb * ES) + (unsigned)C_ * 2u; }
    const unsigned rowb = (unsigned)(lda * ES);
    const size_t kstep = (size_t)(BK * 2), hstep = (size_t)HALF * ldb * ES, tstep = 2 * hstep;
    const unsigned ldsw = (unsigned)wid * 1024u;
    const int aoff = lds_byte(wr * 64 + fr, fq * 8), boff = lds_byte(wc * 32 + fr, fq * 8);
    const int ob8 = fr * 64 + (fq & 1) * 32, sw8 = ob8 ^ (((ob8 >> 9) & 1) << 5);
    const int aoff8 = (wr * 8 + (fq >> 1)) * 1024 + sw8, boff8 = (wc * 4 + (fq >> 1)) * 1024 + sw8;
    LAS int* idxb = (LAS int*)(lds + IDX_OFF);
#define PG8_SA(b, h) (((b) * 2 + (h)) * HTB)
#define PG8_SB(b, h) ((4 + (b) * 2 + (h)) * HTB)
#define PG8_STAGE(bufoff, gbase, voff) do { _Pragma("unroll") for (int _i = 0; _i < 2; ++_i) \
        __builtin_amdgcn_global_load_lds((const unsigned*)((const char*)(gbase) + (voff)[_i]), (LAS unsigned*)(lds + (bufoff) + ldsw + _i * 8192), 16, 0, 0); } while (0)
#define PG8_LDA(dst, b, h) do { if constexpr (ES == 2) { _Pragma("unroll") for (int m = 0; m < 4; ++m) _Pragma("unroll") for (int k = 0; k < 2; ++k) dst[m][k] = *(const LAS bf16x8*)(lds + PG8_SA(b, h) + aoff + m * 2048 + k * 1024); } \
        else { _Pragma("unroll") for (int m = 0; m < 4; ++m) { const u32x4 lo_ = *(const LAS u32x4*)(lds + PG8_SA(b, h) + aoff8 + m * 2048), hi_ = *(const LAS u32x4*)(lds + PG8_SA(b, h) + aoff8 + m * 2048 + 16); \
            dst##8[m] = (i32x8){(int)lo_.x, (int)lo_.y, (int)lo_.z, (int)lo_.w, (int)hi_.x, (int)hi_.y, (int)hi_.z, (int)hi_.w}; } } } while (0)
#define PG8_LDB(dst, b, h) do { if constexpr (ES == 2) { _Pragma("unroll") for (int n = 0; n < 2; ++n) _Pragma("unroll") for (int k = 0; k < 2; ++k) dst[n][k] = *(const LAS bf16x8*)(lds + PG8_SB(b, h) + boff + n * 2048 + k * 1024); } \
        else { _Pragma("unroll") for (int n = 0; n < 2; ++n) { const u32x4 lo_ = *(const LAS u32x4*)(lds + PG8_SB(b, h) + boff8 + n * 2048), hi_ = *(const LAS u32x4*)(lds + PG8_SB(b, h) + boff8 + n * 2048 + 16); \
            dst##8[n] = (i32x8){(int)lo_.x, (int)lo_.y, (int)lo_.z, (int)lo_.w, (int)hi_.x, (int)hi_.y, (int)hi_.z, (int)hi_.w}; } } } while (0)
#define PG8_MMA(ai, bj, At, Bt) do { __builtin_amdgcn_s_setprio(1); if constexpr (ES == 2) { _Pragma("unroll") for (int m = 0; m < 4; ++m) _Pragma("unroll") for (int n = 0; n < 2; ++n) _Pragma("unroll") for (int k = 0; k < 2; ++k) \
        acc[ai][bj][m][n] = __builtin_amdgcn_mfma_f32_16x16x32_bf16(Bt[n][k], At[m][k], acc[ai][bj][m][n], 0, 0, 0); } \
        else { _Pragma("unroll") for (int m = 0; m < 4; ++m) _Pragma("unroll") for (int n = 0; n < 2; ++n) \
        acc[ai][bj][m][n] = __builtin_amdgcn_mfma_scale_f32_16x16x128_f8f6f4(Bt##8[n], At##8[m], acc[ai][bj][m][n], 0, 0, 0, 0x7F7F7F7F, 0, 0x7F7F7F7F); } \
        __builtin_amdgcn_s_setprio(0); } while (0)
#define PG8_WAIT_V(n) asm volatile("s_waitcnt vmcnt(" #n ")" ::: "memory")
#define PG8_WAIT_L(n) asm volatile("s_waitcnt lgkmcnt(" #n ")" ::: "memory")
#define PG8_BAR __builtin_amdgcn_s_barrier()
#define PG8_SCHED __builtin_amdgcn_sched_barrier(0)
#define PG8_ROWOFFS_H(v, u, slot, h_) do { _Pragma("unroll") for (int i_ = 0; i_ < 2; ++i_) { int R_, C_; stage_rc(tid * 16 + i_ * 8192, R_, C_); \
        const int row_ = Sched::GATHER ? idxb[(slot) * 256 + (h_) * HALF + R_] : ((u) * BM + (h_) * HALF + R_); v[h_][i_] = (unsigned)row_ * rowb + (unsigned)C_ * 2u; } } while (0)
    int c_pm, c_pn, c_pb, c_ko, n_pm = 0, n_pn = 0, n_pb = 0, n_ko = 0; int ui = 0;
    { Unit t_; if (!S.next(0, t_)) return; c_pm = t_.pm; c_pn = t_.pn; c_pb = t_.pb; c_ko = t_.kofs; }
#define CUR_U (Unit{c_pm, c_pn, c_pb, c_ko})
#define NXT_U (Unit{n_pm, n_pn, n_pb, n_ko})
    f32x4 acc[2][2][4][2];
#pragma unroll
    for (int a = 0; a < 2; ++a)
#pragma unroll
        for (int b = 0; b < 2; ++b)
#pragma unroll
            for (int m = 0; m < 4; ++m)
#pragma unroll
                for (int n = 0; n < 2; ++n) acc[a][b][m][n] = (f32x4){0.f, 0.f, 0.f, 0.f};
    bf16x8 At[4][2], B0[2][2], B1[2][2]; i32x8 At8[4], B08[2], B18[2];
    unsigned vAc[2][2];
    const char* Ak = (const char*)Ab + (size_t)c_ko * ES;
    const char* cB = (const char*)Btb + (size_t)c_pb * tstep + (size_t)c_ko * ES;
    if constexpr (Sched::GATHER) {
        if (wid == 0) __builtin_amdgcn_global_load_lds((const unsigned*)(S.idx_ptr(CUR_U) + lane * 4), (LAS unsigned*)(idxb), 16, 0, 0);
        PG8_WAIT_V(0); PG8_BAR;
    }
    PG8_ROWOFFS_H(vAc, c_pm, 0, 0); PG8_ROWOFFS_H(vAc, c_pm, 0, 1);
    PG8_STAGE(PG8_SB(0, 0), cB, voffB); PG8_STAGE(PG8_SB(0, 1), cB + hstep, voffB); PG8_STAGE(PG8_SA(0, 0), Ak, vAc[0]); PG8_STAGE(PG8_SA(0, 1), Ak, vAc[1]);
    if (wr == 1) PG8_BAR;
    PG8_WAIT_V(2); PG8_BAR;
    PG8_STAGE(PG8_SB(1, 0), cB + kstep, voffB); PG8_STAGE(PG8_SA(1, 0), Ak + kstep, vAc[0]); PG8_STAGE(PG8_SB(1, 1), cB + hstep + kstep, voffB);
    PG8_WAIT_V(6); PG8_BAR;
    for (;;) {
        bool has_next; { Unit t_; has_next = S.next(ui + 1, t_); if (has_next) { n_pm = t_.pm; n_pn = t_.pn; n_pb = t_.pb; n_ko = t_.kofs; } }
        const char* nB = has_next ? (const char*)Btb + (size_t)n_pb * tstep + (size_t)n_ko * ES : cB;
        const char* nAk = has_next ? (const char*)Ab + (size_t)n_ko * ES : Ak;
#pragma unroll 1
        for (int t = 0; t < nt; t += 2) {
            const bool last = (t == nt - 2);
            if constexpr (Sched::GATHER) { if (t == 0 && has_next && wid == 0)
                __builtin_amdgcn_global_load_lds((const unsigned*)(S.idx_ptr(NXT_U) + lane * 4), (LAS unsigned*)(idxb + ((ui + 1) & 1) * 256), 16, 0, 0); }
            if constexpr (Epi::HOOK) { if (t == 8 || t == 16) E.hook(acc, CUR_U, t >> 3, wr, wc, fr, fq); }
            const bool roll = last && has_next;
            if (roll) PG8_ROWOFFS_H(vAc, n_pm, (ui + 1) & 1, 0);
            const char* a1 = Ak + (size_t)(t + 1) * kstep;
            const char* a2 = last ? nAk : Ak + (size_t)(t + 2) * kstep; const char* b2 = last ? nB : cB + (size_t)(t + 2) * kstep;
            const char* a3 = a2 + kstep; const char* b3 = b2 + kstep;
            PG8_LDB(B0, 0, 0); PG8_LDB(B1, 0, 1); PG8_SCHED; PG8_LDA(At, 0, 0); PG8_STAGE(PG8_SA(1, 1), a1, vAc[1]);
            if (roll) PG8_ROWOFFS_H(vAc, n_pm, (ui + 1) & 1, 1);
            PG8_WAIT_V(8); PG8_WAIT_L(0); PG8_BAR; PG8_MMA(0, 0, At, B0); PG8_MMA(0, 1, At, B1); PG8_BAR; PG8_SCHED;
            PG8_LDA(At, 0, 1); PG8_STAGE(PG8_SB(0, 0), b2, voffB); PG8_STAGE(PG8_SB(0, 1), b2 + hstep, voffB); PG8_STAGE(PG8_SA(0, 0), a2, vAc[0]);
            PG8_WAIT_V(8); PG8_WAIT_L(0); PG8_BAR; PG8_MMA(1, 0, At, B0); PG8_MMA(1, 1, At, B1); PG8_BAR; PG8_SCHED;
            PG8_LDB(B0, 1, 0); PG8_LDB(B1, 1, 1); PG8_SCHED; PG8_LDA(At, 1, 0); PG8_STAGE(PG8_SA(0, 1), a2, vAc[1]);
            PG8_WAIT_V(8); PG8_WAIT_L(0); PG8_BAR; PG8_MMA(0, 0, At, B0); PG8_MMA(0, 1, At, B1); PG8_BAR; PG8_SCHED;
            PG8_LDA(At, 1, 1); PG8_STAGE(PG8_SB(1, 0), b3, voffB); PG8_STAGE(PG8_SB(1, 1), b3 + hstep, voffB); PG8_STAGE(PG8_SA(1, 0), a3, vAc[0]);
            PG8_WAIT_V(8); PG8_WAIT_L(0); PG8_BAR; PG8_MMA(1, 0, At, B0); PG8_MMA(1, 1, At, B1); PG8_BAR; PG8_SCHED;
        }
        if (wr == 0) PG8_BAR;
        E(acc, CUR_U, wr, wc, fr, fq);
        if (!has_next) break;
#pragma unroll
        for (int a = 0; a < 2; ++a)
#pragma unroll
            for (int b = 0; b < 2; ++b)
#pragma unroll
                for (int m = 0; m < 4; ++m)
#pragma unroll
                    for (int n = 0; n < 2; ++n) acc[a][b][m][n] = (f32x4){0.f, 0.f, 0.f, 0.f};
        c_pm = n_pm; c_pn = n_pn; c_pb = n_pb; c_ko = n_ko; cB = nB; Ak = nAk; ++ui;
        if (wr == 1) PG8_BAR;
    }
    PG8_WAIT_V(0);
    PG8_BAR;
#undef PG8_SA
#undef PG8_SB
#undef PG8_STAGE
#undef PG8_LDA
#undef PG8_LDB
#undef PG8_MMA
#undef PG8_WAIT_V
#undef PG8_WAIT_L
#undef PG8_BAR
#undef PG8_SCHED
#undef PG8_ROWOFFS_H
#undef CUR_U
#undef NXT_U
}

#ifndef EPI_SC1
#define EPI_SC1 0
#endif
__device__ __forceinline__ void st16(const void* base, void* p, u32x4 v) {
    if (EPI_SC1) { const __amdgpu_buffer_rsrc_t rs = __builtin_amdgcn_make_buffer_rsrc((void*)base, 0, 0xFFFFFFFF, 0x00020000);
        __builtin_amdgcn_raw_buffer_store_b128(v, rs, (int)(unsigned)((const char*)p - (const char*)base), 0, 16); }
    else *(u32x4*)p = v; }
__device__ __forceinline__ void st16f(const void* base, void* p, f32x4 v) { st16(base, p, __builtin_bit_cast(u32x4, v)); }
__device__ __forceinline__ void st8(const void* base, void* p, u32x2 v) {
    if (EPI_SC1) { const __amdgpu_buffer_rsrc_t rs = __builtin_amdgcn_make_buffer_rsrc((void*)base, 0, 0xFFFFFFFF, 0x00020000);
        __builtin_amdgcn_raw_buffer_store_b64(v, rs, (int)(unsigned)((const char*)p - (const char*)base), 0, 16); }
    else *(u32x2*)p = v; }
struct EpiWin {
    static constexpr bool PERM = true, HOOK = false;
    bf16* P; const float* rope; const float* gbias; float oscale;
    __device__ __forceinline__ void operator()(const f32x4 (&acc)[2][2][4][2], const Unit& u, int wr, int wc, int fr, int fq) const {
        const int row0 = u.pm * BM + wr * 64 + fr, col0 = u.pn * BM + wc * 32 + 8 * fq;
#pragma unroll
        for (int ai = 0; ai < 2; ++ai)
#pragma unroll
            for (int m = 0; m < 4; ++m) { const int r = row0 + ai * HALF + m * 16; bf16* rowp = P + (size_t)r * PSTR + col0;
#pragma unroll
                for (int bj = 0; bj < 2; ++bj) { f32x4 v0 = acc[ai][bj][m][0] * oscale, v1 = acc[ai][bj][m][1] * oscale; const int c = col0 + bj * HALF;
                    if (u.pn < 3 && c < OVA && r < RL) { const int s = r & (SEQ - 1), pi0 = (c & 63) >> 1;
                        const f32x4 cs = *(const f32x4*)(rope + s * 32 + pi0), sn = *(const f32x4*)(rope + SEQ * 32 + s * 32 + pi0);
                        const f32x4 a0 = v0, a1 = v1;
                        v0[0] = a0[0] * cs[0] - a0[1] * sn[0]; v0[1] = a0[0] * sn[0] + a0[1] * cs[0]; v0[2] = a0[2] * cs[1] - a0[3] * sn[1]; v0[3] = a0[2] * sn[1] + a0[3] * cs[1];
                        v1[0] = a1[0] * cs[2] - a1[1] * sn[2]; v1[1] = a1[0] * sn[2] + a1[1] * cs[2]; v1[2] = a1[2] * cs[3] - a1[3] * sn[3]; v1[3] = a1[2] * sn[3] + a1[3] * cs[3]; }
                    if (c >= OBG && c < DIN) { const f32x4 b0 = *(const f32x4*)(gbias + (c - OBG)), b1 = *(const f32x4*)(gbias + (c - OBG) + 4);
#pragma unroll
                        for (int j = 0; j < 4; ++j) { v0[j] = __builtin_amdgcn_rcpf(1.0f + __expf(-(v0[j] + b0[j]))); v1[j] = __builtin_amdgcn_rcpf(1.0f + __expf(-(v1[j] + b1[j]))); } }
                    u32x4 w; w.x = cvt_pk_bf16(v0[0], v0[1]); w.y = cvt_pk_bf16(v0[2], v0[3]); w.z = cvt_pk_bf16(v1[0], v1[1]); w.w = cvt_pk_bf16(v1[2], v1[3]);
                    st16(P, (void*)(rowp + bj * HALF), w); } }
    }
};
struct EpiBf {
    static constexpr bool PERM = true, HOOK = false;
    bf16* O; int ldc;
    __device__ __forceinline__ void operator()(const f32x4 (&acc)[2][2][4][2], const Unit& u, int wr, int wc, int fr, int fq) const {
        const int row0 = u.pm * BM + wr * 64 + fr, col0 = u.pn * BM + wc * 32 + 8 * fq;
#pragma unroll
        for (int ai = 0; ai < 2; ++ai)
#pragma unroll
            for (int m = 0; m < 4; ++m) { bf16* rowp = O + (size_t)(row0 + ai * HALF + m * 16) * ldc + col0;
#pragma unroll
                for (int bj = 0; bj < 2; ++bj) { const f32x4 v0 = acc[ai][bj][m][0], v1 = acc[ai][bj][m][1];
                    u32x4 w; w.x = cvt_pk_bf16(v0[0], v0[1]); w.y = cvt_pk_bf16(v0[2], v0[3]); w.z = cvt_pk_bf16(v1[0], v1[1]); w.w = cvt_pk_bf16(v1[2], v1[3]);
                    st16(O, (void*)(rowp + bj * HALF), w); } }
    }
};
struct EpiF8 {
    static constexpr bool PERM = true, HOOK = false;
    unsigned char* O; int ldc; float scale;
    __device__ __forceinline__ void operator()(const f32x4 (&acc)[2][2][4][2], const Unit& u, int wr, int wc, int fr, int fq) const {
        const int row0 = u.pm * BM + wr * 64 + fr, col0 = u.pn * BM + wc * 32 + 8 * fq;
#pragma unroll
        for (int ai = 0; ai < 2; ++ai)
#pragma unroll
            for (int m = 0; m < 4; ++m) { unsigned char* rowp = O + (size_t)(row0 + ai * HALF + m * 16) * ldc + col0;
#pragma unroll
                for (int bj = 0; bj < 2; ++bj) { const f32x4 v0 = acc[ai][bj][m][0] * scale, v1 = acc[ai][bj][m][1] * scale;
                    u32x2 w; w.x = pk4_fp8(v0[0], v0[1], v0[2], v0[3]); w.y = pk4_fp8(v1[0], v1[1], v1[2], v1[3]);
                    st8(O, (void*)(rowp + bj * HALF), w); } }
    }
};
struct EpiWout {
    static constexpr int NST = 16;
    static constexpr bool PERM = true, HOOK = false;
    bf16* Y; const float* mod; int g; float ascale;
    __device__ __forceinline__ void operator()(const f32x4 (&acc)[2][2][4][2], const Unit& u, int wr, int wc, int fr, int fq) const {
        const int rt = u.pm * BM; const int mrow = rt < RL ? (g * GB + (rt >> 11)) : 16;
        const int row0 = rt + wr * 64 + fr, col0 = u.pn * BM + wc * 32 + 8 * fq;
        const float* g1 = mod + (size_t)mrow * 6144 + 2048 + col0;
        f32x4 gv[2][2];
#pragma unroll
        for (int bj = 0; bj < 2; ++bj)
#pragma unroll
            for (int n = 0; n < 2; ++n) gv[bj][n] = *(const f32x4*)(g1 + bj * HALF + n * 4) * ascale;
#pragma unroll
        for (int ai = 0; ai < 2; ++ai)
#pragma unroll
            for (int m = 0; m < 4; ++m) { bf16* rowp = Y + (size_t)(row0 + ai * HALF + m * 16) * D + col0;
#pragma unroll
                for (int bj = 0; bj < 2; ++bj) { const f32x4 v0 = acc[ai][bj][m][0] * gv[bj][0], v1 = acc[ai][bj][m][1] * gv[bj][1];
                    u32x4 w; w.x = cvt_pk_bf16(v0[0], v0[1]); w.y = cvt_pk_bf16(v0[2], v0[3]); w.z = cvt_pk_bf16(v1[0], v1[1]); w.w = cvt_pk_bf16(v1[2], v1[3]);
                    st16(Y, (void*)(rowp + bj * HALF), w); } }
    }
};
struct EpiMoe1 {
    static constexpr bool PERM = true, HOOK = false;
    bf16* H; const float* roww; int h8;
    __device__ __forceinline__ void operator()(const f32x4 (&acc)[2][2][4][2], const Unit& u, int wr, int wc, int fr, int fq) const {
        const int row0 = u.pm * BM + wr * 64 + fr, col0 = u.pn * HALF + wc * 32 + 8 * fq;
#pragma unroll
        for (int ai = 0; ai < 2; ++ai)
#pragma unroll
            for (int m = 0; m < 4; ++m) { const int r = row0 + ai * HALF + m * 16; const float w = roww[r];
                float o[8];
#pragma unroll
                for (int n = 0; n < 2; ++n)
#pragma unroll
                    for (int j = 0; j < 4; ++j) { const float gv = acc[ai][0][m][n][j] * (FP8_MOE1 ? 1.0f / WIN_SCALE : 1.0f); o[n * 4 + j] = w * gv * __builtin_amdgcn_rcpf(1.0f + __expf(-gv)) * (acc[ai][1][m][n][j] * (FP8_MOE1 ? 1.0f / WIN_SCALE : 1.0f)); }
                if (h8) { u32x2 q8; q8.x = pk4_fp8(o[0] * H_SCALE, o[1] * H_SCALE, o[2] * H_SCALE, o[3] * H_SCALE); q8.y = pk4_fp8(o[4] * H_SCALE, o[5] * H_SCALE, o[6] * H_SCALE, o[7] * H_SCALE);
                    st8(H, (void*)((unsigned char*)H + (size_t)r * EFF + col0), q8); }
                else { u32x4 q; q.x = cvt_pk_bf16(o[0], o[1]); q.y = cvt_pk_bf16(o[2], o[3]); q.z = cvt_pk_bf16(o[4], o[5]); q.w = cvt_pk_bf16(o[6], o[7]);
                    st16(H, (void*)(H + (size_t)r * EFF + col0), q); } }
    }
};
struct EpiMerge {
    static constexpr bool PERM = true, HOOK = true;
    bf16* O; const bf16* P;
    __device__ __forceinline__ static float gclamp(float g) { return fmaxf(g, 1e-20f); }
    __device__ __forceinline__ void hook(f32x4 (&acc)[2][2][4][2], const Unit& u, int seg  , int wr, int wc, int fr, int fq) const {
        int row0 = u.pm * BM + wr * 64 + fr; asm volatile("" : "+v"(row0));
        const unsigned off0 = ((unsigned)row0 * PSTR + OBG + (seg - 1) * D + u.pn * BM + wc * 32 + 8 * fq) * 2u;
        const char* Pb = (const char*)P;
#pragma unroll
        for (int ai = 0; ai < 2; ++ai) {
            u32x4 ga[4][2], gb[4][2];
#pragma unroll
            for (int m = 0; m < 4; ++m)
#pragma unroll
                for (int bj = 0; bj < 2; ++bj) { const unsigned off = off0 + (unsigned)((ai * HALF + m * 16) * PSTR * 2);
                    ga[m][bj] = *(const u32x4*)(Pb + off + bj * HALF * 2); gb[m][bj] = *(const u32x4*)(Pb + off + (D + bj * HALF) * 2); }
            asm volatile("" ::: "memory");
#pragma unroll
            for (int m = 0; m < 4; ++m)
#pragma unroll
                for (int bj = 0; bj < 2; ++bj)
#pragma unroll
                    for (int e = 0; e < 4; ++e) { const float r0 = gclamp(blo(ga[m][bj][e])) * __builtin_amdgcn_rcpf(gclamp(blo(gb[m][bj][e]))), r1 = gclamp(bhi(ga[m][bj][e])) * __builtin_amdgcn_rcpf(gclamp(bhi(gb[m][bj][e])));
                        acc[ai][bj][m][e >> 1][(e & 1) * 2] *= r0; acc[ai][bj][m][e >> 1][(e & 1) * 2 + 1] *= r1; }
            asm volatile("" ::: "memory"); }
    }
    __device__ __forceinline__ void operator()(const f32x4 (&acc)[2][2][4][2], const Unit& u, int wr, int wc, int fr, int fq) const {
        const int row0 = u.pm * BM + wr * 64 + fr, col0 = u.pn * BM + wc * 32 + 8 * fq;
#pragma unroll
        for (int ai = 0; ai < 2; ++ai)
#pragma unroll
            for (int m = 0; m < 4; ++m) { const int r = row0 + ai * HALF + m * 16; const bf16* gp = P + (size_t)r * PSTR + OBG + 2 * D + col0;
#pragma unroll
                for (int bj = 0; bj < 2; ++bj) { const u32x4 gc = *(const u32x4*)(gp + bj * HALF); const f32x4 v0 = acc[ai][bj][m][0], v1 = acc[ai][bj][m][1];
                    u32x4 w; w.x = cvt_pk_bf16(v0[0] * gclamp(blo(gc[0])), v0[1] * gclamp(bhi(gc[0]))); w.y = cvt_pk_bf16(v0[2] * gclamp(blo(gc[1])), v0[3] * gclamp(bhi(gc[1])));
                    w.z = cvt_pk_bf16(v1[0] * gclamp(blo(gc[2])), v1[1] * gclamp(bhi(gc[2]))); w.w = cvt_pk_bf16(v1[2] * gclamp(blo(gc[3])), v1[3] * gclamp(bhi(gc[3])));
                    st16(O, (void*)(O + (size_t)r * D + col0 + bj * HALF), w); } }
    }
};
struct EpiMerge3 {
    static constexpr bool PERM = true, HOOK = false;
    bf16* O; bf16* PA; const bf16* P; unsigned char* O8; float ascale, pad_;
    __device__ __forceinline__ void operator()(const f32x4 (&acc)[2][2][4][2], const Unit& u, int wr, int wc, int fr, int fq) const {
        const int seg = u.kofs >> 9;
        const unsigned row0 = (unsigned)(u.pm * BM + wr * 64 + fr), col0 = (unsigned)(u.pn * BM + wc * 32 + 8 * fq);
        const char* srcb = (const char*)((seg == 1) ? PA : O); char* dstb = (char*)((seg == 0) ? PA : O); const char* Pb = (const char*)P;
        const unsigned goff0 = (row0 * PSTR + OBG + (unsigned)seg * D + col0) * 2u, yoff0 = (row0 * D + col0) * 2u;
#pragma unroll
        for (int ai = 0; ai < 2; ++ai)
#pragma unroll
            for (int mh = 0; mh < 2; ++mh) {
                u32x4 gg[2][2], pp[2][2];
#pragma unroll
                for (int m2 = 0; m2 < 2; ++m2)
#pragma unroll
                    for (int bj = 0; bj < 2; ++bj) { const unsigned rr = (unsigned)(ai * HALF + (mh * 2 + m2) * 16);
                        gg[m2][bj] = *(const u32x4*)(Pb + goff0 + rr * (PSTR * 2) + bj * HALF * 2);
                        pp[m2][bj] = *(const u32x4*)(srcb + yoff0 + rr * (D * 2) + bj * HALF * 2); }
#pragma unroll
                for (int m2 = 0; m2 < 2; ++m2)
#pragma unroll
                    for (int bj = 0; bj < 2; ++bj) { const int m = mh * 2 + m2; const unsigned rr = (unsigned)(ai * HALF + m * 16); const f32x4 v0 = acc[ai][bj][m][0] * ascale, v1 = acc[ai][bj][m][1] * ascale; const u32x4 g = gg[m2][bj];
                        u32x4 p = pp[m2][bj]; if (seg == 0) p = (u32x4){0u, 0u, 0u, 0u};
                        float o[8]; o[0] = blo(p[0]) + v0[0] * blo(g[0]); o[1] = bhi(p[0]) + v0[1] * bhi(g[0]); o[2] = blo(p[1]) + v0[2] * blo(g[1]); o[3] = bhi(p[1]) + v0[3] * bhi(g[1]);
                        o[4] = blo(p[2]) + v1[0] * blo(g[2]); o[5] = bhi(p[2]) + v1[1] * bhi(g[2]); o[6] = blo(p[3]) + v1[2] * blo(g[3]); o[7] = bhi(p[3]) + v1[3] * bhi(g[3]);
                        if (seg == 2 && O8) { u32x2 w8; w8.x = pk4_fp8(o[0] * YM_SCALE, o[1] * YM_SCALE, o[2] * YM_SCALE, o[3] * YM_SCALE); w8.y = pk4_fp8(o[4] * YM_SCALE, o[5] * YM_SCALE, o[6] * YM_SCALE, o[7] * YM_SCALE);
                            *(u32x2*)(O8 + (yoff0 >> 1) + rr * D + bj * HALF) = w8; }
                        else { u32x4 w; w.x = cvt_pk_bf16(o[0], o[1]); w.y = cvt_pk_bf16(o[2], o[3]); w.z = cvt_pk_bf16(o[4], o[5]); w.w = cvt_pk_bf16(o[6], o[7]);
                            *(u32x4*)(dstb + yoff0 + rr * (D * 2) + bj * HALF * 2) = w; } }
                asm volatile("" ::: "memory"); }
    }
};
}

struct Args { const float* in[27]; float* out; unsigned char* ws; int ph_lo, ph_hi; };
struct Frame {
    LAS unsigned char* lds;
    int tid, lane, wave, G, gtid, nthr, gwave, nwave;
    unsigned char* ws;
    const __attribute__((address_space(4))) Args* a;
};
#define gMOD ((float*)(F.ws + (WS_MOD)))
#define gROPE ((float*)(F.ws + (WS_ROPE)))
#define gX ((float*)(F.ws + (WS_X)))
#define gHDIR ((float*)(F.ws + (WS_HDIR)))
#define gA ((bf16*)(F.ws + (WS_A)))
#define gP ((bf16*)(F.ws + (WS_P)))
#define gYATT ((bf16*)(F.ws + (WS_YATT)))
#define gYMLS (gYATT + 512)
#define gYCONV (gYATT + 1024)
#define gYP ((bf16*)(F.ws + (WS_YP)))
#define gYMERGE ((bf16*)(F.ws + (WS_YMERGE)))
#define gH ((bf16*)(F.ws + (WS_H)))
#define gYS ((bf16*)(F.ws + (WS_YS)))
#define gEIDX ((int*)(F.ws + (WS_ROUTE + RT_EIDX)))
#define gEW ((float*)(F.ws + (WS_ROUTE + RT_EW)))
#define gSPOS ((int*)(F.ws + (WS_ROUTE + RT_SPOS)))
#define gROWTOK ((int*)(F.ws + (WS_ROUTE + RT_ROWTOK)))
#define gROWW ((float*)(F.ws + (WS_ROUTE + RT_ROWW)))
#define gTILEE ((int*)(F.ws + (WS_ROUTE + RT_TILEE)))
#define gNT ((int*)(F.ws + (WS_ROUTE + RT_NT)))
#define gCTL ((unsigned*)(F.ws + (WS_CTL)))
#define i_x (F.a->in[0])
#define i_c (F.a->in[1])
#define i_ctx (F.a->in[2])
#define i_c_ctx (F.a->in[3])
#define i_ada_w (F.a->in[4])
#define i_ada_b (F.a->in[5])
#define i_norm1_g (F.a->in[6])
#define i_norm2_g (F.a->in[7])
#define i_w_in (F.a->in[8])
#define i_attn_sink (F.a->in[9])
#define i_gate_b (F.a->in[10])
#define i_mnorm_g (F.a->in[11])
#define i_conv_w (F.a->in[12])
#define i_w_br0 (F.a->in[13])
#define i_w_br1 (F.a->in[14])
#define i_w_br2 (F.a->in[15])
#define i_bgate_b (F.a->in[16])
#define i_w_out (F.a->in[17])
#define i_router_w (F.a->in[18])
#define i_router_b (F.a->in[19])
#define i_ew_gate (F.a->in[20])
#define i_ew_up (F.a->in[21])
#define i_ew_down (F.a->in[22])
#define i_sw_gate (F.a->in[23])
#define i_sw_up (F.a->in[24])
#define i_sw_down (F.a->in[25])
#define i_final_g (F.a->in[26])
#define i_out (F.a->out)
#define gA8 ((unsigned char*)(F.ws + WS_A8))
#define gWRT ((bf16*)(F.ws + WS_ROPE + 512 * 1024))
__device__ __forceinline__ int row_batch(int g, int r) { return g * GB + (r < RL ? (r >> 11) : ((r - RL) >> 8)); }
__device__ __forceinline__ int row_modrow(int g, int r) { return r < RL ? row_batch(g, r) : 16; }
__device__ __forceinline__ const float* row_input(const Frame& F, int g, int r) {
    if (r < RL) return i_x + ((size_t)(g * GB + (r >> 11)) * SEQ + (r & 2047)) * D;
    const int rc = r - RL; return i_ctx + ((size_t)(g * GB + (rc >> 8)) * CTXL + (rc & 255)) * D;
}

__device__ __forceinline__ void ph_prologue(Frame& F) {
    for (int i = F.gtid; i < SEQ * 32; i += F.nthr) {
        const int s = i >> 5, pi = i & 31, j = pi & 15;
        const float pos = (pi < 16) ? (float)(s >> 6) : (float)(s & 63);
        const float invf = exp2f(-(float)j * (13.287712379549449f / 16.0f));
        const float ang = pos * invf;
        gROPE[i] = __cosf(ang); gROPE[SEQ * 32 + i] = __sinf(ang);
    }
    for (int i = F.gtid; i < DEPTH * NE * D; i += F.nthr) { const int l = i / (NE * D), e = (i / D) % NE, k = i % D;
        const float w = i_router_w[((size_t)l * D + k) * NE + e]; const unsigned hi = f2bf(w);
        gWRT[(size_t)l * 2 * NE * D + e * D + k] = (bf16)hi; gWRT[(size_t)l * 2 * NE * D + NE * D + e * D + k] = (bf16)f2bf(w - __uint_as_float(hi << 16)); }
    LAS float* sl = (LAS float*)F.lds;
    LAS float* red = (LAS float*)(F.lds + 17 * 1024 * 4);
    for (int i = F.tid; i < 17 * 1024; i += NTHR) { const int row = i >> 10, k = i & 1023; const float v = row < 16 ? i_c[row * 1024 + k] : i_c_ctx[k]; sl[i] = v / (1.0f + __expf(-v)); }
    __syncthreads();
    for (int item = blockIdx.x; item < DEPTH * 192; item += F.G) {
        const int l = item / 192, n0 = (item % 192) * 32, col = F.tid & 31, ks = F.tid >> 5;
        float acc[17];
#pragma unroll
        for (int r = 0; r < 17; ++r) acc[r] = 0.f;
        const float* wp = i_ada_w + ((size_t)l * 1024 + ks * 64) * 6144 + n0 + col;
#pragma unroll 8
        for (int kk = 0; kk < 64; ++kk) { const float w = wp[(size_t)kk * 6144];
#pragma unroll
            for (int r = 0; r < 17; ++r) acc[r] += sl[r * 1024 + ks * 64 + kk] * w; }
#pragma unroll
        for (int r = 0; r < 17; ++r) red[(ks * 17 + r) * 32 + col] = acc[r];
        __syncthreads();
        for (int o = F.tid; o < 17 * 32; o += NTHR) { const int r = o >> 5, cc = o & 31; float s = 0.f;
#pragma unroll
            for (int k2 = 0; k2 < 16; ++k2) s += red[(k2 * 17 + r) * 32 + cc];
            gMOD[((size_t)l * 17 + r) * 6144 + n0 + cc] = s + i_ada_b[l * 6144 + n0 + cc]; }
        __syncthreads();
    }
}

__device__ __forceinline__ void norm_mod_store_bf16(const f32x4 (&v)[4], const float* gain, const float* sh, const float* sc, bf16* orow, int lane) {
    float ss = 0.f;
#pragma unroll
    for (int j = 0; j < 4; ++j) ss += (v[j].x * v[j].x + v[j].y * v[j].y) + (v[j].z * v[j].z + v[j].w * v[j].w);
    const float rs = rsqrtf(wave_sum(ss) * (1.0f / D) + EPS);
#pragma unroll
    for (int j = 0; j < 4; ++j) { const int c0 = 4 * lane + 256 * j;
        const f32x4 gq = *(const f32x4*)(gain + c0), sq = *(const f32x4*)(sc + c0), hq = *(const f32x4*)(sh + c0);
        const f32x4 o = v[j] * rs * gq * (sq + 1.0f) + hq;
        u32x2 w; w.x = pk2(o.x, o.y); w.y = pk2(o.z, o.w); *(u32x2*)(orow + c0) = w; }
}
__device__ __forceinline__ void norm_mod_store_fp8(const f32x4 (&v)[4], const float* gain, const float* sh, const float* sc, unsigned char* orow, int lane) {
    float ss = 0.f;
#pragma unroll
    for (int j = 0; j < 4; ++j) ss += (v[j].x * v[j].x + v[j].y * v[j].y) + (v[j].z * v[j].z + v[j].w * v[j].w);
    const float rs = rsqrtf(wave_sum(ss) * (1.0f / D) + EPS);
#pragma unroll
    for (int j = 0; j < 4; ++j) { const int c0 = 4 * lane + 256 * j;
        const f32x4 gq = *(const f32x4*)(gain + c0), sq = *(const f32x4*)(sc + c0), hq = *(const f32x4*)(sh + c0);
        const f32x4 o = v[j] * rs * gq * (sq + 1.0f) + hq;
        *(unsigned*)(orow + c0) = pk4_fp8(o.x, o.y, o.z, o.w); }
}
__device__ __forceinline__ void ph_norm1_input(Frame& F, int g) {
    for (int r = F.gwave; r < R; r += F.nwave) {
        const float* xr = row_input(F, g, r); f32x4 v[4];
#pragma unroll
        for (int j = 0; j < 4; ++j) v[j] = *(const f32x4*)(xr + 4 * F.lane + 256 * j);
        const float* mod = gMOD + (size_t)(0 * 17 + row_modrow(g, r)) * 6144;
        if (FP8_WIN_L(0)) norm_mod_store_fp8(v, i_norm1_g, mod, mod + 1024, gA8 + (size_t)r * D, F.lane); else norm_mod_store_bf16(v, i_norm1_g, mod, mod + 1024, gA + (size_t)r * D, F.lane);
    }
}
__device__ __forceinline__ void ph_combine(Frame& F, int g, int l) {
    typedef float f32x2_ __attribute__((ext_vector_type(2)));
    const int nrows = (l == 0) ? R : RL; const int spsh = gNT[1] * 256;
    const unsigned char* yp8 = (const unsigned char*)gYP;
    const int c0 = 16 * F.lane;
    constexpr int QR = 2;
    int spn[QR][8];
#define CMB_ROW(rb_, q_) (((rb_) + (q_) * F.nwave < nrows) ? (rb_) + (q_) * F.nwave : (rb_))
#define CMB_LOADSP(rb_) do { _Pragma("unroll") for (int q_ = 0; q_ < QR; ++q_) { const int r_ = CMB_ROW(rb_, q_); _Pragma("unroll") for (int s_ = 0; s_ < 8; ++s_) spn[q_][s_] = gSPOS[r_ * 8 + s_]; } } while (0)
    if (F.gwave < nrows) CMB_LOADSP(F.gwave);
    for (int rb = F.gwave; rb < nrows; rb += QR * F.nwave) {
        int rr[QR];
#pragma unroll
        for (int q = 0; q < QR; ++q) rr[q] = CMB_ROW(rb, q);
        f32x4 xv[QR][4]; u32x4 pw[QR][9]; f32x4 g2v[QR][4];
#pragma unroll
        for (int q = 0; q < QR; ++q) { const int r = rr[q];
            const float* mod = gMOD + (size_t)(l * 17 + row_modrow(g, r)) * 6144;
#pragma unroll
            for (int j = 0; j < 4; ++j) { xv[q][j] = *(const f32x4*)(gX + (size_t)r * D + c0 + 4 * j); g2v[q][j] = *(const f32x4*)(mod + 5120 + c0 + 4 * j); }
            pw[q][8] = *(const u32x4*)(yp8 + (size_t)(spsh + r) * D + c0);
#pragma unroll
            for (int s = 0; s < 8; ++s) pw[q][s] = *(const u32x4*)(yp8 + (size_t)spn[q][s] * D + c0); }
        if (rb + QR * F.nwave < nrows) CMB_LOADSP(rb + QR * F.nwave);
#pragma unroll
        for (int q = 0; q < QR; ++q) { const int r = rr[q];
            f32x4 v[4];
#pragma unroll
            for (int j = 0; j < 4; ++j) { f32x4 m = (f32x4){0.f, 0.f, 0.f, 0.f};
#pragma unroll
                for (int s = 0; s < 9; ++s) { const unsigned w = pw[q][s][j]; const f32x2_ lo = __builtin_amdgcn_cvt_pk_f32_fp8((int)w, false), hi = __builtin_amdgcn_cvt_pk_f32_fp8((int)w, true); m += (f32x4){lo.x, lo.y, hi.x, hi.y}; }
                v[j] = xv[q][j] + g2v[q][j] * (m * (1.0f / YP_SCALE)); }
            float ss = 0.f;
#pragma unroll
            for (int j = 0; j < 4; ++j) ss += (v[j].x * v[j].x + v[j].y * v[j].y) + (v[j].z * v[j].z + v[j].w * v[j].w);
            const float rs = rsqrtf(wave_sum(ss) * (1.0f / D) + EPS);
            if (l == 0) {
#pragma unroll
                for (int j = 0; j < 4; ++j) *(f32x4*)(gX + (size_t)r * D + c0 + 4 * j) = v[j];
                const float* mod1 = gMOD + (size_t)(1 * 17 + row_modrow(g, r)) * 6144;
                f32x4 o[4];
#pragma unroll
                for (int j = 0; j < 4; ++j) o[j] = v[j] * rs * *(const f32x4*)(i_norm1_g + D + c0 + 4 * j) * (*(const f32x4*)(mod1 + 1024 + c0 + 4 * j) + 1.0f) + *(const f32x4*)(mod1 + c0 + 4 * j);
                if (FP8_WIN_L(1)) { u32x4 w;
#pragma unroll
                    for (int j = 0; j < 4; ++j) w[j] = pk4_fp8(o[j].x, o[j].y, o[j].z, o[j].w);
                    *(u32x4*)(gA8 + (size_t)r * D + c0) = w; }
                else { u32x4 w0, w1; w0.x = pk2(o[0].x, o[0].y); w0.y = pk2(o[0].z, o[0].w); w0.z = pk2(o[1].x, o[1].y); w0.w = pk2(o[1].z, o[1].w);
                    w1.x = pk2(o[2].x, o[2].y); w1.y = pk2(o[2].z, o[2].w); w1.z = pk2(o[3].x, o[3].y); w1.w = pk2(o[3].z, o[3].w);
                    *(u32x4*)(gA + (size_t)r * D + c0) = w0; *(u32x4*)(gA + (size_t)r * D + c0 + 8) = w1; }
            } else {
                float* orow = i_out + ((size_t)(g * GB + (r >> 11)) * SEQ + (r & 2047)) * D;
#pragma unroll
                for (int j = 0; j < 4; ++j) *(f32x4*)(orow + c0 + 4 * j) = v[j] * rs * *(const f32x4*)(i_final_g + c0 + 4 * j);
            }
        }
    }
}

#undef CMB_ROW
#undef CMB_LOADSP
__device__ __forceinline__ void ngemm_acc(float (&acc)[4][4], const bf16* a0, const bf16* a1, const bf16* a2, const bf16* a3, const float* B, int ldb, int c0, int K) {
    for (int k = 0; k < K; k += 8) {
        const u32x4 q0 = *(const u32x4*)(a0 + k), q1 = *(const u32x4*)(a1 + k), q2 = *(const u32x4*)(a2 + k), q3 = *(const u32x4*)(a3 + k);
#pragma unroll
        for (int kk = 0; kk < 8; ++kk) {
            const f32x4 b = *(const f32x4*)(B + (size_t)(k + kk) * ldb + c0);
            const unsigned w0 = q0[kk >> 1], w1 = q1[kk >> 1], w2 = q2[kk >> 1], w3 = q3[kk >> 1];
            const float x0 = (kk & 1) ? bhi(w0) : blo(w0), x1 = (kk & 1) ? bhi(w1) : blo(w1), x2 = (kk & 1) ? bhi(w2) : blo(w2), x3 = (kk & 1) ? bhi(w3) : blo(w3);
            acc[0][0] += x0 * b.x; acc[0][1] += x0 * b.y; acc[0][2] += x0 * b.z; acc[0][3] += x0 * b.w;
            acc[1][0] += x1 * b.x; acc[1][1] += x1 * b.y; acc[1][2] += x1 * b.z; acc[1][3] += x1 * b.w;
            acc[2][0] += x2 * b.x; acc[2][1] += x2 * b.y; acc[2][2] += x2 * b.z; acc[2][3] += x2 * b.w;
            acc[3][0] += x3 * b.x; acc[3][1] += x3 * b.y; acc[3][2] += x3 * b.z; acc[3][3] += x3 * b.w;
        }
    }
}
#define ZERO44(a) do { _Pragma("unroll") for (int i_ = 0; i_ < 4; ++i_) _Pragma("unroll") for (int j_ = 0; j_ < 4; ++j_) a[i_][j_] = 0.f; } while (0)

__device__ __forceinline__ void ph_win_naive(Frame& F, int l) {
    const int nq = DIN / 4; const long total = (long)(R / 4) * nq;
    const float* B = i_w_in + (size_t)l * D * DIN;
    for (long it = F.gtid; it < total; it += F.nthr) {
        const int rq = (int)(it / nq), cq = (int)(it % nq), r0 = rq * 4, c0 = cq * 4;
        float acc[4][4]; ZERO44(acc);
        const bf16* a = gA + (size_t)r0 * D;
        ngemm_acc(acc, a, a + D, a + 2 * D, a + 3 * D, B, DIN, c0, D);
        if (c0 >= OBG) { const f32x4 bb = *(const f32x4*)(i_bgate_b + (size_t)l * 3 * D + (c0 - OBG));
#pragma unroll
            for (int i = 0; i < 4; ++i) { acc[i][0] = sigmoidf_(acc[i][0] + bb.x); acc[i][1] = sigmoidf_(acc[i][1] + bb.y); acc[i][2] = sigmoidf_(acc[i][2] + bb.z); acc[i][3] = sigmoidf_(acc[i][3] + bb.w); } }
#pragma unroll
        for (int i = 0; i < 4; ++i) { u32x2 w; w.x = pk2(acc[i][0], acc[i][1]); w.y = pk2(acc[i][2], acc[i][3]); *(u32x2*)(gP + (size_t)(r0 + i) * PSTR + c0) = w; }
    }
}
__device__ __forceinline__ void ph_rope(Frame& F) {
    const long total = (long)RL * 320;
    for (long it = F.gtid; it < total; it += F.nthr) {
        const int r = (int)(it / 320), pp = (int)(it % 320);
        const int s = r & 2047;
        const int col = (pp < 256) ? (OQA + pp * 2) : (OKA + (pp - 256) * 2);
        const int pi = pp & 31;
        const float cs = gROPE[s * 32 + pi], sn = gROPE[SEQ * 32 + s * 32 + pi];
        unsigned* p = (unsigned*)(gP + (size_t)r * PSTR + col);
        const unsigned w = *p; const float x0 = blo(w), x1 = bhi(w);
        *p = pk2(x0 * cs - x1 * sn, x0 * sn + x1 * cs);
    }
}
__device__ __forceinline__ void ph_attn_naive(Frame& F, int l) {
    const int nqr = (l == 0) ? R : RL; const long total = (long)nqr * 8;
    for (long it = F.gtid; it < total; it += F.nthr) {
        const int h = (int)(it / nqr), r = (int)(it % nqr), kvh = h >> 2;
        float q[64], o[64];
        { const bf16* qp = gP + (size_t)r * PSTR + OQA + h * 64;
#pragma unroll
          for (int c = 0; c < 8; ++c) { const u32x4 w = *(const u32x4*)(qp + c * 8);
#pragma unroll
              for (int e = 0; e < 4; ++e) { q[c * 8 + 2 * e] = blo(w[e]) * 0.125f; q[c * 8 + 2 * e + 1] = bhi(w[e]) * 0.125f; } } }
#pragma unroll
        for (int d = 0; d < 64; ++d) o[d] = 0.f;
        float m = i_attn_sink[l * 8 + h], lsum = 1.0f;
        const int bl = (r < RL) ? (r >> 11) : ((r - RL) >> 8);
        int lo = 0, hi = -1;
        if (r < RL) { const int s = r & 2047; lo = s - 128 < 0 ? 0 : s - 128; hi = s + 128 > 2047 ? 2047 : s + 128; }
        const int nk = 256 + (hi - lo + 1);
        for (int kk = 0; kk < nk; ++kk) {
            const int krow = (kk < 256) ? (RL + bl * 256 + kk) : (bl * 2048 + lo + (kk - 256));
            const bf16* kp = gP + (size_t)krow * PSTR + OKA + kvh * 64; const bf16* vp = gP + (size_t)krow * PSTR + OVA + kvh * 64;
            float sc = 0.f;
#pragma unroll
            for (int c = 0; c < 8; ++c) { const u32x4 w = *(const u32x4*)(kp + c * 8);
#pragma unroll
                for (int e = 0; e < 4; ++e) sc += q[c * 8 + 2 * e] * blo(w[e]) + q[c * 8 + 2 * e + 1] * bhi(w[e]); }
            if (sc > m) { const float corr = __expf(m - sc); lsum *= corr;
#pragma unroll
                for (int d = 0; d < 64; ++d) o[d] *= corr;
                m = sc; }
            const float p = __expf(sc - m); lsum += p;
#pragma unroll
            for (int c = 0; c < 8; ++c) { const u32x4 w = *(const u32x4*)(vp + c * 8);
#pragma unroll
                for (int e = 0; e < 4; ++e) { o[c * 8 + 2 * e] += p * blo(w[e]); o[c * 8 + 2 * e + 1] += p * bhi(w[e]); } }
        }
        const float inv = 1.0f / lsum;
        bf16* op = gYATT + (size_t)r * YCS + h * 64;
#pragma unroll
        for (int c = 0; c < 8; ++c) { u32x4 w;
#pragma unroll
            for (int e = 0; e < 4; ++e) w[e] = pk2(o[c * 8 + 2 * e] * inv, o[c * 8 + 2 * e + 1] * inv);
            *(u32x4*)(op + c * 8) = w; }
    }
}
__device__ __forceinline__ void ph_mlstm_naive(Frame& F, int l) {
    for (int item = blockIdx.x; item < GB * 4 * 2; item += F.G) {
        const int bl = item >> 3, h = (item >> 1) & 3, dir = item & 1;
        const int e = F.tid >> 2, dq = F.tid & 3;
        float C[16], n[16];
#pragma unroll
        for (int d = 0; d < 16; ++d) { C[d] = 0.f; n[d] = 0.f; }
        const float bi = i_gate_b[l * 16 + (dir * 2 + 0) * 4 + h], bfg = i_gate_b[l * 16 + (dir * 2 + 1) * 4 + h];
        for (int step = 0; step < CTXL + SEQ; ++step) {
            int r;
            if (step < CTXL) { const int j = dir ? (CTXL - 1 - step) : step; r = RL + bl * CTXL + j; }
            else { const int s0 = step - CTXL; const int s = dir ? (SEQ - 1 - s0) : s0; r = bl * SEQ + s; }
            const bf16* row = gP + (size_t)r * PSTR;
            const float ig = bf2f(row[OGM + (dir * 2) * 4 + h]) + bi, fg = bf2f(row[OGM + (dir * 2 + 1) * 4 + h]) + bfg;
            const float fgate = sigmoidf_(fg), igate = __expf(ig);
            const float v = bf2f(row[OVM + h * 128 + e]);
            const u32x4 k0 = *(const u32x4*)(row + OKM + h * 64 + dq * 16), k1 = *(const u32x4*)(row + OKM + h * 64 + dq * 16 + 8);
            const u32x4 q0 = *(const u32x4*)(row + OQM + h * 64 + dq * 16), q1 = *(const u32x4*)(row + OQM + h * 64 + dq * 16 + 8);
            float hq = 0.f, nq = 0.f; const float iv = igate * v;
#pragma unroll
            for (int d = 0; d < 16; ++d) {
                const unsigned kw = (d < 8) ? k0[d >> 1] : k1[(d - 8) >> 1], qw = (d < 8) ? q0[d >> 1] : q1[(d - 8) >> 1];
                const float kd = ((d & 1) ? bhi(kw) : blo(kw)) * 0.125f, qd = (d & 1) ? bhi(qw) : blo(qw);
                C[d] = fgate * C[d] + iv * kd; n[d] = fgate * n[d] + igate * kd;
                hq += C[d] * qd; nq += n[d] * qd;
            }
            hq += __shfl_xor(hq, 1); hq += __shfl_xor(hq, 2); nq += __shfl_xor(nq, 1); nq += __shfl_xor(nq, 2);
            const float hv = hq / fmaxf(fabsf(nq), 1.0f);
            if (dq == 0 && (l == 0 || step >= CTXL)) gHDIR[((size_t)dir * R + r) * 512 + h * 128 + e] = hv;
        }
    }
}
__device__ __forceinline__ void ph_conv(Frame& F, int l) {
    const int nrows = (l == 0) ? R : RL; const long total = (long)nrows * 64;
    const float* cw = i_conv_w + (size_t)l * 3 * 512;
    for (long it = F.gtid; it < total; it += F.nthr) {
        const int r = (int)(it >> 6), c0 = (int)(it & 63) * 8;
        int pos, len; if (r < RL) { pos = r & 2047; len = SEQ; } else { pos = (r - RL) & 255; len = CTXL; }
        float acc[8];
#pragma unroll
        for (int e = 0; e < 8; ++e) acc[e] = 0.f;
#pragma unroll
        for (int t = 0; t < 3; ++t) { const int pp = pos + t - 1; if (pp < 0 || pp >= len) continue;
            const bf16* row = gP + (size_t)(r + t - 1) * PSTR;
            const u32x4 cq = *(const u32x4*)(row + OCC + c0), xq = *(const u32x4*)(row + OXC + c0);
#pragma unroll
            for (int e = 0; e < 4; ++e) { acc[2 * e] += cw[t * 512 + c0 + 2 * e] * blo(cq[e]) * blo(xq[e]); acc[2 * e + 1] += cw[t * 512 + c0 + 2 * e + 1] * bhi(cq[e]) * bhi(xq[e]); } }
        const u32x4 bq = *(const u32x4*)(gP + (size_t)r * PSTR + OBC + c0);
#pragma unroll
        for (int e = 0; e < 4; ++e) { acc[2 * e] *= blo(bq[e]); acc[2 * e + 1] *= bhi(bq[e]); }
        if (FP8_MRG_L(l)) { u32x2 w8; w8.x = pk4_fp8(acc[0], acc[1], acc[2], acc[3]); w8.y = pk4_fp8(acc[4], acc[5], acc[6], acc[7]); *(u32x2*)((unsigned char*)gYATT + (size_t)r * YCS + 1024 + c0) = w8; }
        else { u32x4 w;
#pragma unroll
            for (int e = 0; e < 4; ++e) w[e] = pk2(acc[2 * e], acc[2 * e + 1]);
            *(u32x4*)(gYCONV + (size_t)r * YCS + c0) = w; }
    }
}
__device__ __forceinline__ void ph_mlstm_final(Frame& F, int l) {
    const int nrows = (l == 0) ? R : RL; const long total = (long)nrows * 4;
    for (long it = F.gwave; it < total; it += F.nwave) {
        const int r = (int)(it >> 2), h = (int)(it & 3), c = h * 128 + 2 * F.lane;
        const float* hf = gHDIR + (size_t)r * 512 + c; const float* hb = gHDIR + ((size_t)R + r) * 512 + c;
        const float h0 = hf[0] + hb[0], h1 = hf[1] + hb[1];
        const float rs = rsqrtf(wave_sum(h0 * h0 + h1 * h1) * (1.0f / 128.0f) + EPS);
        const unsigned ow = *(const unsigned*)(gP + (size_t)r * PSTR + OOM + c);
        const float g0 = i_mnorm_g[l * 512 + c], g1 = i_mnorm_g[l * 512 + c + 1];
        *(unsigned*)(gYMLS + (size_t)r * YCS + c) = pk2(sigmoidf_(blo(ow)) * h0 * rs * g0, sigmoidf_(bhi(ow)) * h1 * rs * g1);
    }
}
__device__ __forceinline__ void ph_merge_naive(Frame& F, int l) {
    const int nrows = (l == 0) ? R : RL; const int nq = D / 4; const long total = (long)(nrows / 4) * nq;
    for (long it = F.gtid; it < total; it += F.nthr) {
        const int rq = (int)(it / nq), cq = (int)(it % nq), r0 = rq * 4, c0 = cq * 4;
        float res[4][4]; ZERO44(res);
#pragma unroll
        for (int b = 0; b < 3; ++b) {
            const bf16* ya = gYATT + (size_t)r0 * YCS + b * 512;
            const float* wb = (b == 0 ? i_w_br0 : b == 1 ? i_w_br1 : i_w_br2) + (size_t)l * 512 * D;
            float acc[4][4]; ZERO44(acc);
            ngemm_acc(acc, ya, ya + YCS, ya + 2 * YCS, ya + 3 * YCS, wb, D, c0, 512);
#pragma unroll
            for (int i = 0; i < 4; ++i) { const u32x2 gw = *(const u32x2*)(gP + (size_t)(r0 + i) * PSTR + OBG + b * D + c0);
                res[i][0] += blo(gw.x) * acc[i][0]; res[i][1] += bhi(gw.x) * acc[i][1];
                res[i][2] += blo(gw.y) * acc[i][2]; res[i][3] += bhi(gw.y) * acc[i][3]; }
        }
#pragma unroll
        for (int i = 0; i < 4; ++i) { u32x2 w; w.x = pk2(res[i][0], res[i][1]); w.y = pk2(res[i][2], res[i][3]); *(u32x2*)(gYMERGE + (size_t)(r0 + i) * D + c0) = w; }
    }
}
__device__ __forceinline__ void ph_wout_naive(Frame& F, int g, int l) {
    const int nrows = (l == 0) ? R : RL; const int nq = D / 4; const long total = (long)(nrows / 4) * nq;
    for (long it = F.gtid; it < total; it += F.nthr) {
        const int rq = (int)(it / nq), cq = (int)(it % nq), r0 = rq * 4, c0 = cq * 4;
        float acc[4][4]; ZERO44(acc);
        const bf16* a = gYMERGE + (size_t)r0 * D;
        ngemm_acc(acc, a, a + D, a + 2 * D, a + 3 * D, i_w_out + (size_t)l * D * D, D, c0, D);
#pragma unroll
        for (int i = 0; i < 4; ++i) { const int r = r0 + i;
            const float* src = (l == 0) ? row_input(F, g, r) : (gX + (size_t)r * D);
            const f32x4 g1 = *(const f32x4*)(gMOD + (size_t)(l * 17 + row_modrow(g, r)) * 6144 + 2048 + c0);
            const f32x4 xv = *(const f32x4*)(src + c0);
            *(f32x4*)(gX + (size_t)r * D + c0) = xv + g1 * (f32x4){acc[i][0], acc[i][1], acc[i][2], acc[i][3]}; }
    }
}
constexpr int RB = 2, WROWS = RB * NWAVES;
#define gWGBASE ((unsigned*)(F.ws + WS_ROUTE + 2 * MiB + 640 * 1024))
__device__ __forceinline__ void ph_norm2_route(Frame& F, int g, int l) {
    const int nrows = (l == 0) ? R : RL, nbatch = nrows / WROWS;
    LAS float* hrow = (LAS float*)F.lds;
    LAS float* part = (LAS float*)(F.lds + 65536);
    LAS unsigned* wcnt = (LAS unsigned*)(F.lds + 65536 + 32768);
    unsigned* fill = gCTL + CW_CNT + (g * DEPTH + l) * 128 + 64;
    const bf16* wrt = gWRT + (size_t)l * 2 * NE * D;
    const float rbias = i_router_b[l * NE + F.lane];
    if (F.tid < 64) wcnt[F.tid] = 0u;
    __syncthreads();
    f32x4 xv[RB][4];
    u32x2 dl[RB][4];
#define ROUTE_LOADX(dst, wb_) do { _Pragma("unroll") for (int i_ = 0; i_ < RB; ++i_) { const int r_ = (wb_) * WROWS + F.wave * RB + i_; \
        const float* sp_ = (l == 0) ? row_input(F, g, r_) : (gX + (size_t)r_ * D); \
        _Pragma("unroll") for (int j_ = 0; j_ < 4; ++j_) { dst[i_][j_] = *(const f32x4*)(sp_ + 4 * F.lane + 256 * j_); dl[i_][j_] = *(const u32x2*)(gH + (size_t)r_ * D + 4 * F.lane + 256 * j_); } } } while (0)
    const int wb_lo = (int)(((long)blockIdx.x * nbatch) / F.G), wb_hi = (int)(((long)(blockIdx.x + 1) * nbatch) / F.G);
    LAS float* gl = (LAS float*)(F.lds + 65536 + 32768 + 1024);
    int cur_mrow = -1;
    if (wb_lo < wb_hi) ROUTE_LOADX(xv, wb_lo);
    for (int wb = wb_lo; wb < wb_hi; ++wb) {
        const bool lastrep = true;
        const int r0 = wb * WROWS + F.wave * RB;
        const int mrow = row_modrow(g, wb * WROWS);
        if (mrow != cur_mrow) { cur_mrow = mrow; const float* mod = gMOD + (size_t)(l * 17 + mrow) * 6144;
            __syncthreads();
            if (F.tid < 256) *(LAS f32x4*)(gl + 4 * F.tid) = *(const f32x4*)(i_norm2_g + l * D + 4 * F.tid) * (*(const f32x4*)(mod + 4096 + 4 * F.tid) + 1.0f);
            else *(LAS f32x4*)(gl + 1024 + 4 * (F.tid - 256)) = *(const f32x4*)(mod + 3072 + 4 * (F.tid - 256));
            __syncthreads(); }
#pragma unroll
        for (int i = 0; i < RB; ++i) { const int r = r0 + i;
            float ss = 0.f;
#pragma unroll
            for (int j = 0; j < 4; ++j) { const u32x2 dw = dl[i][j]; const f32x4 x = xv[i][j] + (f32x4){blo(dw.x), bhi(dw.x), blo(dw.y), bhi(dw.y)}; xv[i][j] = x;
                *(f32x4*)(gX + (size_t)r * D + 4 * F.lane + 256 * j) = x;
                ss += (x.x * x.x + x.y * x.y) + (x.z * x.z + x.w * x.w); }
            const float rs = rsqrtf(wave_sum(ss) * (1.0f / D) + EPS);
#pragma unroll
            for (int j = 0; j < 4; ++j) { const int c0 = 4 * F.lane + 256 * j;
                const f32x4 o = xv[i][j] * rs * *(const LAS f32x4*)(gl + c0) + *(const LAS f32x4*)(gl + 1024 + c0);
                if (FP8_MOE1) *(unsigned*)(gA8 + (size_t)r * D + c0) = pk4_fp8(o.x, o.y, o.z, o.w);
                else { u32x2 w; w.x = pk2(o.x, o.y); w.y = pk2(o.z, o.w); *(u32x2*)(gA + (size_t)r * D + c0) = w; }
                *(LAS f32x4*)(hrow + (F.wave * RB + i) * 1024 + c0) = o; }
            asm volatile("" ::: "memory"); __builtin_amdgcn_sched_barrier(0); }
        if (wb + 1 < wb_hi) ROUTE_LOADX(xv, wb + 1);
        __builtin_amdgcn_sched_barrier(0);
        const int ar = F.lane & 15, kq = (F.lane >> 4) * 8;
        bf16x8 wfh[2][4], wfl[2][4];
#define ROUTE_LOADW(slot, ks_) do { _Pragma("unroll") for (int et_ = 0; et_ < 4; ++et_) { const bf16* wp_ = wrt + (size_t)(et_ * 16 + ar) * D + F.wave * 128 + (ks_) * 32 + kq; \
            wfh[slot][et_] = *(const bf16x8*)wp_; wfl[slot][et_] = *(const bf16x8*)(wp_ + (size_t)NE * D); } } while (0)
        ROUTE_LOADW(0, 0);
        __syncthreads();
        { f32x4 acc[4];
#pragma unroll
          for (int et = 0; et < 4; ++et) acc[et] = (f32x4){0.f, 0.f, 0.f, 0.f};
#define ROUTE_STEP(slot, ks_) do { const int k8 = F.wave * 128 + (ks_) * 32 + kq; \
              const f32x4 x0 = *(const LAS f32x4*)(hrow + ar * 1024 + k8), x1 = *(const LAS f32x4*)(hrow + ar * 1024 + k8 + 4); \
              u32x4 hw, lw; \
              hw.x = pk2(x0.x, x0.y); hw.y = pk2(x0.z, x0.w); hw.z = pk2(x1.x, x1.y); hw.w = pk2(x1.z, x1.w); \
              lw.x = pk2(x0.x - blo(hw.x), x0.y - bhi(hw.x)); lw.y = pk2(x0.z - blo(hw.y), x0.w - bhi(hw.y)); lw.z = pk2(x1.x - blo(hw.z), x1.y - bhi(hw.z)); lw.w = pk2(x1.z - blo(hw.w), x1.w - bhi(hw.w)); \
              const bf16x8 ah = __builtin_bit_cast(bf16x8, hw), al = __builtin_bit_cast(bf16x8, lw); \
              _Pragma("unroll") for (int et = 0; et < 4; ++et) { const bf16x8 bh = wfh[slot][et], bl = wfl[slot][et]; \
                  acc[et] = __builtin_amdgcn_mfma_f32_16x16x32_bf16(ah, bh, acc[et], 0, 0, 0); \
                  acc[et] = __builtin_amdgcn_mfma_f32_16x16x32_bf16(al, bh, acc[et], 0, 0, 0); \
                  acc[et] = __builtin_amdgcn_mfma_f32_16x16x32_bf16(ah, bl, acc[et], 0, 0, 0); } } while (0)
#pragma unroll 1
          for (int kk = 0; kk < 4; kk += 2) {
              ROUTE_LOADW(1, kk + 1); __builtin_amdgcn_sched_barrier(0); ROUTE_STEP(0, kk); __builtin_amdgcn_sched_barrier(0);
              if (kk + 2 < 4) ROUTE_LOADW(0, kk + 2);
              __builtin_amdgcn_sched_barrier(0); ROUTE_STEP(1, kk + 1); __builtin_amdgcn_sched_barrier(0); }
#undef ROUTE_STEP
#undef ROUTE_LOADW
#pragma unroll
          for (int et = 0; et < 4; ++et)
#pragma unroll
              for (int j = 0; j < 4; ++j) part[(F.wave * 16 + (F.lane >> 4) * 4 + j) * 64 + et * 16 + ar] = acc[et][j]; }
        __syncthreads();
#pragma unroll
        for (int i = 0; i < RB; ++i) { const int r = r0 + i; float lgt = 0.f;
#pragma unroll
            for (int w = 0; w < 8; ++w) lgt += part[(w * 16 + F.wave * RB + i) * 64 + F.lane];
            const float score = sigmoidf_(lgt), sel = score + rbias;
            const float m1 = oct_max(sel);
            const unsigned long long e1 = __ballot(sel == m1);
            const int w1 = __builtin_ctz((unsigned)((e1 >> (F.lane & ~7)) & 0xFFull));
            const float m2 = oct_max(((F.lane & 7) == w1) ? -INFINITY : sel);
            const float gs = m1 + m2;
            float gcur = gs; bool gsel = false;
#pragma unroll 1
            for (int k = 0; k < 4; ++k) { const float mx = wave_max(gcur); const unsigned long long bm = __ballot(gcur == mx); const int wg_ = __builtin_ctzll(bm) >> 3;
                if ((F.lane >> 3) == wg_) { gsel = true; gcur = -INFINITY; } }
            float cur = gsel ? sel : -INFINITY;
            int erk = 8;
#pragma unroll 1
            for (int k = 0; k < TOPK; ++k) { const float mx = wave_max(cur);
                const unsigned long long bm = __ballot(cur == mx); const int win = __builtin_ctzll(bm);
                if (F.lane == win) { erk = k; cur = -INFINITY; } }
            const bool chosen = erk < 8;
            const float wsum = wave_sum(chosen ? score : 0.f);
            if (chosen && lastrep) { const unsigned li = __hip_atomic_fetch_add(wcnt + F.lane, 1u, __ATOMIC_RELAXED, __HIP_MEMORY_SCOPE_WORKGROUP);
                gEIDX[r * 8 + erk] = F.lane; gEW[r * 8 + erk] = score / wsum * 2.5f; gSPOS[r * 8 + erk] = (int)li; }
            else if (chosen) gEW[r * 8 + erk] = score / wsum * 2.5f;
        }
        __syncthreads();
    }
#undef ROUTE_LOADX
    __syncthreads();
    if (F.tid < 64) { const unsigned c = wcnt[F.tid]; gWGBASE[blockIdx.x * 64 + F.tid] = c ? __hip_atomic_fetch_add(fill + F.tid, c, RLX_AGENT) : 0u; }
}
__device__ __forceinline__ void ph_scatter(Frame& F, int g, int l) {
    const int nrows = (l == 0) ? R : RL;
    unsigned* fill = gCTL + CW_CNT + (g * DEPTH + l) * 128 + 64;
    const unsigned c = __hip_atomic_load(fill + F.lane, RLX_AGENT), pad = (c + 255u) & ~255u;
    unsigned incl = pad;
#pragma unroll
    for (int o = 1; o < 64; o <<= 1) { const unsigned t = __shfl_up(incl, o); if (F.lane >= o) incl += t; }
    const unsigned off = incl - pad;
    const long total = (long)nrows * 8;
    const long iters = (total + F.nthr - 1) / F.nthr;
    for (long k = 0; k < iters; ++k) {
        const long it = k * F.nthr + F.gtid; const bool act = it < total;
        const int e = act ? gEIDX[it] : 0;
        const unsigned base = __shfl(off, e);
        if (act) { const int row = (int)(it >> 3); const int nbatch_ = nrows / WROWS; const int wg = (int)((((long)(row / WROWS) + 1) * F.G - 1) / nbatch_);
            const unsigned pos = base + gWGBASE[wg * 64 + e] + (unsigned)gSPOS[it]; gROWTOK[pos] = row; gROWW[pos] = gEW[it]; gSPOS[it] = (int)pos; }
    }
    const unsigned ntr = __shfl(incl, 63) / 256u;
    for (int r = F.gtid; r < nrows; r += F.nthr) { gROWTOK[ntr * 256u + r] = r; gROWW[ntr * 256u + r] = 1.0f; }
    if (F.wave == 0) for (int e = (int)blockIdx.x; e < NE; e += F.G) {
        const unsigned ce = __shfl(c, e), pade = __shfl(pad, e), offe = __shfl(off, e);
        for (unsigned p = ce + F.lane; p < pade; p += 64u) { gROWTOK[offe + p] = 0; gROWW[offe + p] = 0.f; }
        for (unsigned t = F.lane; t < pade / 256u; t += 64u) gTILEE[offe / 256u + t] = e;
    }
    if ((int)blockIdx.x == F.G - 1 && F.wave == 0) {
        if (F.lane < nrows / 256) gTILEE[ntr + F.lane] = NE;
        if (F.lane == 63) { gNT[0] = (int)ntr + nrows / 256; gNT[1] = (int)ntr; }
    }
}
__device__ __forceinline__ void ph_moe1_naive(Frame& F, int l) {
    const int nt = gNT[0]; const int nq = EFF / 4; const long tot = (long)(nt * 256 / 4) * nq;
    for (long it = F.gtid; it < tot; it += F.nthr) {
        const int rq = (int)(it / nq), cq = (int)(it % nq), r0 = rq * 4, c0 = cq * 4;
        const int e = gTILEE[r0 >> 8];
        const float* Wg = e < NE ? (i_ew_gate + ((size_t)l * NE + e) * D * EFF) : (i_sw_gate + (size_t)l * D * EFF);
        const float* Wu = e < NE ? (i_ew_up + ((size_t)l * NE + e) * D * EFF) : (i_sw_up + (size_t)l * D * EFF);
        const bf16 *a0 = gA + (size_t)gROWTOK[r0] * D, *a1 = gA + (size_t)gROWTOK[r0 + 1] * D, *a2 = gA + (size_t)gROWTOK[r0 + 2] * D, *a3 = gA + (size_t)gROWTOK[r0 + 3] * D;
        float ag[4][4], au[4][4]; ZERO44(ag); ZERO44(au);
        ngemm_acc(ag, a0, a1, a2, a3, Wg, EFF, c0, D);
        ngemm_acc(au, a0, a1, a2, a3, Wu, EFF, c0, D);
#pragma unroll
        for (int i = 0; i < 4; ++i) { float o[4]; const float w = gROWW[r0 + i];
#pragma unroll
            for (int j = 0; j < 4; ++j) { const float gv = ag[i][j]; o[j] = w * (gv / (1.0f + __expf(-gv))) * au[i][j]; }
            u32x2 q; q.x = pk2(o[0], o[1]); q.y = pk2(o[2], o[3]); *(u32x2*)(gH + (size_t)(r0 + i) * EFF + c0) = q; }
    }
}
__device__ __forceinline__ void ph_moe2_naive(Frame& F, int l) {
    const int nt = gNT[0]; const int nq = D / 4; const long tot = (long)(nt * 256 / 4) * nq;
    for (long it = F.gtid; it < tot; it += F.nthr) {
        const int rq = (int)(it / nq), cq = (int)(it % nq), r0 = rq * 4, c0 = cq * 4;
        const int e = gTILEE[r0 >> 8];
        const bf16* a = gH + (size_t)r0 * EFF;
        const float* Wd = e < NE ? (i_ew_down + ((size_t)l * NE + e) * EFF * D) : (i_sw_down + (size_t)l * EFF * D);
        float acc[4][4]; ZERO44(acc);
        ngemm_acc(acc, a, a + EFF, a + 2 * EFF, a + 3 * EFF, Wd, D, c0, EFF);
#pragma unroll
        for (int i = 0; i < 4; ++i) { u32x2 q; q.x = pk2(acc[i][0], acc[i][1]); q.y = pk2(acc[i][2], acc[i][3]); *(u32x2*)(gYP + (size_t)(r0 + i) * D + c0) = q; }
    }
}

typedef float f32x16 __attribute__((ext_vector_type(16)));
constexpr int NCHK = 36, NSEQ = GB * 4 * 2, LDP = 72;
__device__ __forceinline__ int crow16(int i, int hi) { return (i & 3) + 8 * (i >> 2) + 4 * hi; }
__device__ __forceinline__ f32x16 mma32(f32x16 acc, const LAS bf16* A, int lda, const LAS bf16* Bt, int ldb, int K16, int lane) {
    const int r = lane & 31, hi = lane >> 5;
    for (int ks = 0; ks < K16; ++ks) {
        const bf16x8 a = *(const LAS bf16x8*)(A + r * lda + ks * 16 + hi * 8), b = *(const LAS bf16x8*)(Bt + r * ldb + ks * 16 + hi * 8);
        acc = __builtin_amdgcn_mfma_f32_32x32x16_bf16(a, b, acc, 0, 0, 0);
    }
    return acc;
}
__device__ __forceinline__ float log_sigmoidf_(float x) { return fminf(x, 0.f) - __logf(1.0f + __expf(-fabsf(x))); }
__device__ __forceinline__ int mchunk_row(int bl, int dir, int jc) {
    if (jc < 4) return RL + bl * CTXL + (dir ? 3 - jc : jc) * 64;
    const int c = jc - 4; return bl * SEQ + (dir ? 31 - c : c) * 64;
}
template <int CTRL, int ROWMASK> __device__ __forceinline__ float dpp_z(float v) {
    return __int_as_float(__builtin_amdgcn_update_dpp(0, __float_as_int(v), CTRL, ROWMASK, 0xF, true)); }
__device__ __forceinline__ void mgates(const bf16* P, int rb, int h, int dir, int l, const float* gate_b, int lane, int& tk, float& b, float& total, float& ig) {
    tk = dir ? 63 - lane : lane;
    const bf16* row = P + (size_t)(rb + tk) * PSTR + OGM;
    ig = bf2f(row[(dir * 2) * 4 + h]) + gate_b[l * 16 + (dir * 2) * 4 + h];
    const float fg = bf2f(row[(dir * 2 + 1) * 4 + h]) + gate_b[l * 16 + (dir * 2 + 1) * 4 + h];
    b = log_sigmoidf_(fg);
    b += dpp_z<0x111, 0xF>(b); b += dpp_z<0x112, 0xF>(b); b += dpp_z<0x114, 0xF>(b); b += dpp_z<0x118, 0xF>(b);
    b += dpp_z<0x142, 0xA>(b); b += dpp_z<0x143, 0xC>(b);
    total = __int_as_float(__builtin_amdgcn_readlane(__float_as_int(b), 63));
}
#define gDC ((float*)(F.ws + WS_HDIR))
#define gDN ((float*)(F.ws + WS_ROUTE + 2 * MiB))
#define gNIN (gDN + NSEQ * NCHK * 64)
#define gDEC (gNIN + NSEQ * NCHK * 64)
#define gCIN ((bf16*)(F.ws + WS_CIN))
__device__ __forceinline__ void ph_mlstm_dc(Frame& F, int l) {
    LAS bf16* VT = (LAS bf16*)F.lds;
    LAS bf16* KwT = VT + 128 * LDP;
    LAS float* wv = (LAS float*)(KwT + 2 * 64 * LDP);
    constexpr int NIT = GB * 4 * NCHK;
    const int nfull_ = NIT / F.G, rem_ = NIT % F.G, nmine_ = nfull_ + ((F.G - 1 - (int)blockIdx.x) < rem_ ? 1 : 0);
    for (int j_ = 0; j_ < nmine_; ++j_) {
        const int item = (j_ < nfull_) ? ((int)blockIdx.x + j_ * F.G) : (nfull_ * F.G + (F.G - 1 - (int)blockIdx.x));
        const int bh = item / NCHK, c = item % NCHK, bl = bh >> 2, h = bh & 3;
        int rb, jc0, jc1;
        if (c < 4) { rb = RL + bl * CTXL + c * 64; jc0 = c; jc1 = 3 - c; } else { const int cc = c - 4; rb = bl * SEQ + cc * 64; jc0 = 4 + cc; jc1 = 4 + 31 - cc; }
        const int it0 = (bl * 8 + h * 2 + 0) * NCHK + jc0, it1 = (bl * 8 + h * 2 + 1) * NCHK + jc1;
        const int t = F.tid >> 3, c8 = F.tid & 7; const bf16* row = gP + (size_t)(rb + t) * PSTR;
        const u32x4 kq = *(const u32x4*)(row + OKM + h * 64 + c8 * 8), v0 = *(const u32x4*)(row + OVM + h * 128 + c8 * 16), v1 = *(const u32x4*)(row + OVM + h * 128 + c8 * 16 + 8);
        if (F.wave < 2) { const int dir = F.wave; int tk; float b, total, ig; mgates(gP, rb, h, dir, l, i_gate_b, F.lane, tk, b, total, ig); wv[dir * 64 + tk] = __expf(total - b + ig); if (F.lane == 0) wv[128 + dir] = __expf(total); }
        __syncthreads();
        { const float w0 = wv[t] * 0.125f, w1 = wv[64 + t] * 0.125f;
#pragma unroll
          for (int e = 0; e < 4; ++e) { const float k0 = blo(kq[e]), k1 = bhi(kq[e]);
              KwT[(c8 * 8 + 2 * e) * LDP + t] = (bf16)f2bf(w0 * k0); KwT[(c8 * 8 + 2 * e + 1) * LDP + t] = (bf16)f2bf(w0 * k1);
              KwT[(64 + c8 * 8 + 2 * e) * LDP + t] = (bf16)f2bf(w1 * k0); KwT[(64 + c8 * 8 + 2 * e + 1) * LDP + t] = (bf16)f2bf(w1 * k1); }
#pragma unroll
          for (int e = 0; e < 4; ++e) { VT[(c8 * 16 + 2 * e) * LDP + t] = (bf16)(v0[e] & 0xffffu); VT[(c8 * 16 + 2 * e + 1) * LDP + t] = (bf16)(v0[e] >> 16);
                                        VT[(c8 * 16 + 8 + 2 * e) * LDP + t] = (bf16)(v1[e] & 0xffffu); VT[(c8 * 16 + 8 + 2 * e + 1) * LDP + t] = (bf16)(v1[e] >> 16); } }
        __syncthreads();
        { const int e0 = (F.wave >> 1) * 32, d0 = (F.wave & 1) * 32, hi = F.lane >> 5;
#pragma unroll
          for (int dir = 0; dir < 2; ++dir) {
              f32x16 acc = {}; acc = mma32(acc, VT + e0 * LDP, LDP, KwT + (dir * 64 + d0) * LDP, LDP, 4, F.lane);
              float* o = gDC + (size_t)(dir ? it1 : it0) * 8192 + d0 + (F.lane & 31);
#pragma unroll
              for (int i = 0; i < 16; ++i) o[(e0 + crow16(i, hi)) * 64] = acc[i]; } }
        if (F.wave < 2) { const int dir = F.wave; float s = 0.f;
#pragma unroll 8
            for (int t = 0; t < 64; ++t) s += bf2f(KwT[(dir * 64 + F.lane) * LDP + t]);
            gDN[(dir ? it1 : it0) * 64 + F.lane] = s; if (F.lane == 0) gDEC[dir ? it1 : it0] = wv[128 + dir]; }
        __syncthreads();
    }
}
__device__ __forceinline__ void ph_mlstm_scan(Frame& F) {
    static_assert(NSEQ * 8192 == 2 * 256 * NTHR, "two matrix elements per thread on a 256-workgroup grid");
    const bool two = F.nthr * 2 == NSEQ * 8192;
    if (two) {
#pragma unroll 1
        for (int h = 0; h < 2; ++h) { const int e0 = F.gtid + h * F.nthr, s0 = e0 >> 13, c0 = e0 & 8191;
            float x0[NCHK], d0[NCHK];
#pragma unroll
            for (int jc = 0; jc < NCHK; ++jc) { d0[jc] = gDEC[s0 * NCHK + jc]; x0[jc] = gDC[(size_t)(s0 * NCHK + jc) * 8192 + c0]; }
            float a = 0.f;
#pragma unroll
            for (int jc = 0; jc < NCHK; ++jc) { gCIN[(size_t)(s0 * NCHK + jc) * 8192 + c0] = (bf16)f2bf(a); a = d0[jc] * a + x0[jc]; } }
        if (F.gtid < NSEQ * 64) { const int sn = F.gtid >> 6, cn = F.gtid & 63; float xn[NCHK], dn[NCHK];
#pragma unroll
            for (int jc = 0; jc < NCHK; ++jc) { dn[jc] = gDEC[sn * NCHK + jc]; xn[jc] = gDN[(sn * NCHK + jc) * 64 + cn]; }
            float c = 0.f;
#pragma unroll
            for (int jc = 0; jc < NCHK; ++jc) { gNIN[(sn * NCHK + jc) * 64 + cn] = c; c = dn[jc] * c + xn[jc]; } }
    } else {
        for (int idx = F.gtid; idx < NSEQ * (8192 + 64); idx += F.nthr) {
            const int seq = idx / (8192 + 64), e = idx % (8192 + 64); const bool isn = e >= 8192; float c = 0.f;
            for (int jc = 0; jc < NCHK; ++jc) { const int item = seq * NCHK + jc;
                if (isn) gNIN[item * 64 + (e - 8192)] = c; else gCIN[(size_t)item * 8192 + e] = (bf16)f2bf(c);
                const float x = isn ? gDN[item * 64 + (e - 8192)] : gDC[(size_t)item * 8192 + e]; c = gDEC[item] * c + x; }
        }
    }
}
__device__ __forceinline__ void ph_mlstm_out(Frame& F, int l) {
    LAS bf16* Qs = (LAS bf16*)F.lds;
    LAS bf16* Ks = Qs + 64 * LDP;
    LAS bf16* VT = Ks + 64 * LDP;
    LAS bf16* Sd = VT + 128 * LDP;
    LAS bf16* Ed = Sd + 2 * 64 * LDP;
    LAS bf16* Cd = Ed + 2 * 64 * LDP;
    LAS float* gt = (LAS float*)(Cd + 2 * 128 * LDP);
    LAS float* hb = gt + 5 * 128;
    constexpr int HBP = 132;
    static_assert((64 * LDP * 2 + 128 * LDP + 4 * 64 * LDP + 2 * 128 * LDP) * 2 + 5 * 128 * 4 + 64 * HBP * 4 <= LDS_BYTES - 16, "mlstm_out LDS");
    const int nch = (l == 0) ? 36 : 32;
    for (int item = blockIdx.x; item < GB * 4 * nch; item += F.G) {
        const int bh = item / nch, c = item % nch, bl = bh >> 2, h = bh & 3;
        int rb, jc0, jc1;
        if (l == 0 && c < 4) { rb = RL + bl * CTXL + c * 64; jc0 = c; jc1 = 3 - c; }
        else { const int cc = (l == 0) ? c - 4 : c; rb = bl * SEQ + cc * 64; jc0 = 4 + cc; jc1 = 4 + 31 - cc; }
        const int it0 = (bl * 8 + h * 2 + 0) * NCHK + jc0, it1 = (bl * 8 + h * 2 + 1) * NCHK + jc1;
        const int t = F.tid >> 3, c8 = F.tid & 7; const bf16* row = gP + (size_t)(rb + t) * PSTR;
        const u32x4 qq = *(const u32x4*)(row + OQM + h * 64 + c8 * 8), kq = *(const u32x4*)(row + OKM + h * 64 + c8 * 8);
        const u32x4 v0 = *(const u32x4*)(row + OVM + h * 128 + c8 * 16), v1 = *(const u32x4*)(row + OVM + h * 128 + c8 * 16 + 8);
        const int e2 = F.tid >> 2, d16 = (F.tid & 3) * 16;
        const bf16* cp0 = gCIN + (size_t)it0 * 8192 + e2 * 64 + d16; const bf16* cp1 = gCIN + (size_t)it1 * 8192 + e2 * 64 + d16;
        const u32x4 c00 = *(const u32x4*)cp0, c01 = *(const u32x4*)(cp0 + 8), c10 = *(const u32x4*)cp1, c11 = *(const u32x4*)(cp1 + 8);
        if (F.wave < 2) { const int dir = F.wave; int tk; float b, total, ig; mgates(gP, rb, h, dir, l, i_gate_b, F.lane, tk, b, total, ig);
            gt[dir * 64 + tk] = b; gt[128 + dir * 64 + tk] = ig - b; gt[256 + dir * 64 + tk] = __expf(b);
            gt[512 + dir * 64 + F.lane] = gNIN[(dir ? it1 : it0) * 64 + F.lane]; }
        { *(LAS u32x4*)(Qs + t * LDP + c8 * 8) = qq;
          u32x4 ks;
#pragma unroll
          for (int e = 0; e < 4; ++e) ks[e] = pk2(blo(kq[e]) * 0.125f, bhi(kq[e]) * 0.125f);
          *(LAS u32x4*)(Ks + t * LDP + c8 * 8) = ks;
#pragma unroll
          for (int e = 0; e < 4; ++e) { VT[(c8 * 16 + 2 * e) * LDP + t] = (bf16)(v0[e] & 0xffffu); VT[(c8 * 16 + 2 * e + 1) * LDP + t] = (bf16)(v0[e] >> 16);
                                        VT[(c8 * 16 + 8 + 2 * e) * LDP + t] = (bf16)(v1[e] & 0xffffu); VT[(c8 * 16 + 8 + 2 * e + 1) * LDP + t] = (bf16)(v1[e] >> 16); }
          *(LAS u32x4*)(Cd + e2 * LDP + d16) = c00; *(LAS u32x4*)(Cd + e2 * LDP + d16 + 8) = c01;
          *(LAS u32x4*)(Cd + (128 + e2) * LDP + d16) = c10; *(LAS u32x4*)(Cd + (128 + e2) * LDP + d16 + 8) = c11; }
        __syncthreads();
        if (F.wave < 4) {
            const int m0 = (F.wave >> 1) * 32, n0 = (F.wave & 1) * 32, hi = F.lane >> 5, tc = n0 + (F.lane & 31);
            f32x16 acc = {}; acc = mma32(acc, Qs + m0 * LDP, LDP, Ks + n0 * LDP, LDP, 4, F.lane);
            const float cw0 = gt[128 + tc], cw1 = gt[128 + 64 + tc];
#pragma unroll
            for (int i = 0; i < 16; ++i) { const int t = m0 + crow16(i, hi);
                const float a0 = (tc <= t) ? __expf(gt[t] + cw0) : 0.f, a1 = (tc >= t) ? __expf(gt[64 + t] + cw1) : 0.f;
                Sd[t * LDP + tc] = (bf16)f2bf(acc[i] * a0); Sd[(64 + t) * LDP + tc] = (bf16)f2bf(acc[i] * a1); }
        } else {
            const int j = F.tid - 256;
            const int t = j >> 2, d16 = (j & 3) * 16;
#pragma unroll
            for (int dir = 0; dir < 2; ++dir) { const float eb = gt[256 + dir * 64 + t];
#pragma unroll
                for (int q8 = 0; q8 < 2; ++q8) { const u32x4 qq = *(const LAS u32x4*)(Qs + t * LDP + d16 + q8 * 8); u32x4 o;
#pragma unroll
                    for (int e = 0; e < 4; ++e) o[e] = pk2(blo(qq[e]) * eb, bhi(qq[e]) * eb);
                    *(LAS u32x4*)(Ed + (dir * 64 + t) * LDP + d16 + q8 * 8) = o; } }
        }
        __syncthreads();
        {
          const int dir = F.tid >> 8, t = (F.tid >> 2) & 63, part = F.tid & 3; float s = 0.f, qn = 0.f;
#pragma unroll
          for (int q8 = 0; q8 < 2; ++q8) { const u32x4 sv = *(const LAS u32x4*)(Sd + (dir * 64 + t) * LDP + part * 16 + q8 * 8), qv = *(const LAS u32x4*)(Qs + t * LDP + part * 16 + q8 * 8);
#pragma unroll
              for (int e = 0; e < 4; ++e) { s += blo(sv[e]) + bhi(sv[e]); qn += blo(qv[e]) * gt[512 + dir * 64 + part * 16 + q8 * 8 + 2 * e] + bhi(qv[e]) * gt[512 + dir * 64 + part * 16 + q8 * 8 + 2 * e + 1]; } }
          s += gt[256 + dir * 64 + t] * qn; s += __shfl_xor(s, 1); s += __shfl_xor(s, 2);
          if (part == 0) gt[384 + dir * 64 + t] = s; }
        f32x16 a0 = {}, a1 = {};
        const int m0 = (F.wave >> 2) * 32, n0 = (F.wave & 3) * 32;
        a0 = mma32(a0, Sd + m0 * LDP, LDP, VT + n0 * LDP, LDP, 4, F.lane); a0 = mma32(a0, Ed + m0 * LDP, LDP, Cd + n0 * LDP, LDP, 4, F.lane);
        a1 = mma32(a1, Sd + (64 + m0) * LDP, LDP, VT + n0 * LDP, LDP, 4, F.lane); a1 = mma32(a1, Ed + (64 + m0) * LDP, LDP, Cd + (128 + n0) * LDP, LDP, 4, F.lane);
        __syncthreads();
        { const int hi = F.lane >> 5, e = n0 + (F.lane & 31);
#pragma unroll
          for (int i = 0; i < 16; ++i) { const int t = m0 + crow16(i, hi);
              hb[t * HBP + e] = a0[i] * __builtin_amdgcn_rcpf(fmaxf(fabsf(gt[384 + t]), 1.0f)) + a1[i] * __builtin_amdgcn_rcpf(fmaxf(fabsf(gt[384 + 64 + t]), 1.0f)); } }
        __syncthreads();
        { const int t = F.tid >> 3, sg = F.tid & 7; float hv[16]; float ss = 0.f;
#pragma unroll
          for (int q4 = 0; q4 < 4; ++q4) { const f32x4 x = *(const LAS f32x4*)(hb + t * HBP + sg * 16 + q4 * 4); hv[q4 * 4] = x.x; hv[q4 * 4 + 1] = x.y; hv[q4 * 4 + 2] = x.z; hv[q4 * 4 + 3] = x.w; ss += (x.x * x.x + x.y * x.y) + (x.z * x.z + x.w * x.w); }
          ss += __shfl_xor(ss, 1); ss += __shfl_xor(ss, 2); ss += __shfl_xor(ss, 4);
          const float rs = rsqrtf(ss * (1.0f / 128.0f) + EPS);
          const bf16* orow = gP + (size_t)(rb + t) * PSTR + OOM + h * 128 + sg * 16; const float* gn = i_mnorm_g + l * 512 + h * 128 + sg * 16;
          bf16* yo = gYMLS + (size_t)(rb + t) * YCS + h * 128 + sg * 16;
          unsigned char* yo8 = (unsigned char*)gYATT + (size_t)(rb + t) * YCS + 512 + h * 128 + sg * 16;
#pragma unroll
          for (int q8 = 0; q8 < 2; ++q8) { const u32x4 ov = *(const u32x4*)(orow + q8 * 8); float yv[8];
#pragma unroll
              for (int e = 0; e < 4; ++e) { const int k = q8 * 8 + 2 * e; yv[2 * e] = sigmoidf_(blo(ov[e])) * hv[k] * rs * gn[k]; yv[2 * e + 1] = sigmoidf_(bhi(ov[e])) * hv[k + 1] * rs * gn[k + 1]; }
              if (FP8_MRG_L(l)) { u32x2 w8; w8.x = pk4_fp8(yv[0], yv[1], yv[2], yv[3]); w8.y = pk4_fp8(yv[4], yv[5], yv[6], yv[7]); *(u32x2*)(yo8 + q8 * 8) = w8; }
              else { u32x4 w; w.x = pk2(yv[0], yv[1]); w.y = pk2(yv[2], yv[3]); w.z = pk2(yv[4], yv[5]); w.w = pk2(yv[6], yv[7]); *(u32x4*)(yo + q8 * 8) = w; } } }
        __syncthreads();
    }
}

__device__ __forceinline__ void ph_attn_mfma(Frame& F, int l) {
    LAS bf16* Kb = (LAS bf16*)F.lds;
    LAS bf16* Vb = Kb + 2 * 64 * LDP;
    constexpr float L2E = 1.4426950408889634f;
    const int nlat = GB * 2 * 32, nctx = (l == 0) ? GB * 2 * 4 : 0;
    const int hi = F.lane >> 5, ql = F.lane & 31;
    for (int item = blockIdx.x; item < nlat + nctx; item += F.G) {
        const bool isctx = item >= nlat;
        int bl, kvh, q0, qrow0, ntile;
        if (!isctx) { bl = item >> 6; kvh = (item >> 5) & 1; q0 = (item & 31) * 64; qrow0 = bl * SEQ + q0; ntile = 9; }
        else { const int j = item - nlat; bl = j >> 3; kvh = (j >> 2) & 1; q0 = (j & 3) * 64; qrow0 = RL + bl * CTXL + q0; ntile = 4; }
        const int hq = kvh * 4 + (F.wave >> 1), qi = (F.wave & 1) * 32 + ql, qr = qrow0 + qi;
        bf16x8 qf[4];
        { const bf16* qp = gP + (size_t)qr * PSTR + OQA + hq * 64 + hi * 8;
#pragma unroll
          for (int ks = 0; ks < 4; ++ks) { const u32x4 w = *(const u32x4*)(qp + ks * 16); u32x4 o;
#pragma unroll
              for (int e = 0; e < 4; ++e) o[e] = pk2(blo(w[e]) * (0.125f * L2E), bhi(w[e]) * (0.125f * L2E));
              qf[ks] = __builtin_bit_cast(bf16x8, o); } }
        float m = i_attn_sink[l * 8 + hq] * L2E, lsum = (hi == 0) ? 1.0f : 0.0f;
        f32x16 O0 = {}, O1 = {};
        const int lk = F.tid >> 3, c8 = F.tid & 7;
        u32x4 kreg, vreg;
#define ATT_LOAD(j) do { int row_; if ((j) < 4) row_ = RL + bl * CTXL + (j) * 64 + lk; else { int kp_ = q0 - 128 + ((j) - 4) * 64 + lk; kp_ = kp_ < 0 ? 0 : (kp_ > SEQ - 1 ? SEQ - 1 : kp_); row_ = bl * SEQ + kp_; } \
        const bf16* rp_ = gP + (size_t)row_ * PSTR + kvh * 64 + c8 * 8; kreg = *(const u32x4*)(rp_ + OKA); vreg = *(const u32x4*)(rp_ + OVA); } while (0)
#define ATT_STORE(buf) do { *(LAS u32x4*)(Kb + ((buf) * 64 + lk) * LDP + c8 * 8) = kreg; \
        _Pragma("unroll") for (int e_ = 0; e_ < 4; ++e_) { Vb[((buf) * 64 + c8 * 8 + 2 * e_) * LDP + lk] = (bf16)(vreg[e_] & 0xffffu); Vb[((buf) * 64 + c8 * 8 + 2 * e_ + 1) * LDP + lk] = (bf16)(vreg[e_] >> 16); } } while (0)
        ATT_LOAD(0); ATT_STORE(0);
        __syncthreads();
        for (int j = 0; j < ntile; ++j) {
            const int buf = j & 1;
            if (j + 1 < ntile) ATT_LOAD(j + 1);
            const LAS bf16* kb = Kb + buf * 64 * LDP; const LAS bf16* vb = Vb + buf * 64 * LDP;
            f32x16 S0 = {}, S1 = {};
#pragma unroll
            for (int ks = 0; ks < 4; ++ks) {
                const bf16x8 a0 = *(const LAS bf16x8*)(kb + ql * LDP + ks * 16 + hi * 8), a1 = *(const LAS bf16x8*)(kb + (32 + ql) * LDP + ks * 16 + hi * 8);
                S0 = __builtin_amdgcn_mfma_f32_32x32x16_bf16(a0, qf[ks], S0, 0, 0, 0); S1 = __builtin_amdgcn_mfma_f32_32x32x16_bf16(a1, qf[ks], S1, 0, 0, 0);
            }
            if (j >= 4) {
                const int kbase = q0 - 128 + (j - 4) * 64, qpos = q0 + qi;
#pragma unroll
                for (int i = 0; i < 16; ++i) { const int kp0 = kbase + crow16(i, hi), kp1 = kp0 + 32;
                    const int d0 = kp0 - qpos, d1 = kp1 - qpos;
                    if (!(kp0 >= 0 && kp0 < SEQ && d0 >= -128 && d0 <= 128)) S0[i] = -INFINITY;
                    if (!(kp1 >= 0 && kp1 < SEQ && d1 >= -128 && d1 <= 128)) S1[i] = -INFINITY; }
            }
            float mx = fmaxf(S0[0], S1[0]);
#pragma unroll
            for (int i = 1; i < 16; ++i) mx = fmaxf(mx, fmaxf(S0[i], S1[i]));
            { auto rr_ = __builtin_amdgcn_permlane32_swap(__float_as_uint(mx), __float_as_uint(mx), false, false); mx = fmaxf(__uint_as_float(rr_[0]), __uint_as_float(rr_[1])); }
            const float mn = fmaxf(m, mx), corr = __builtin_amdgcn_exp2f(m - mn); const bool grew = __any(mn > m); m = mn;
            float ps = 0.f;
#pragma unroll
            for (int i = 0; i < 16; ++i) { S0[i] = __builtin_amdgcn_exp2f(S0[i] - mn); S1[i] = __builtin_amdgcn_exp2f(S1[i] - mn); ps += S0[i] + S1[i]; }
            lsum = lsum * corr + ps;
            if (grew) {
#pragma unroll
            for (int i = 0; i < 16; ++i) { O0[i] *= corr; O1[i] *= corr; } }
#pragma unroll
            for (int sub = 0; sub < 2; ++sub)
#pragma unroll
                for (int jj = 0; jj < 2; ++jj) {
                    u32x4 pw;
#pragma unroll
                    for (int e = 0; e < 4; ++e) pw[e] = sub ? pk2(S1[8 * jj + 2 * e], S1[8 * jj + 2 * e + 1]) : pk2(S0[8 * jj + 2 * e], S0[8 * jj + 2 * e + 1]);
                    const bf16x8 pf = __builtin_bit_cast(bf16x8, pw);
                    const int kk = sub * 32 + jj * 16 + 4 * hi;
                    u32x2 va0 = *(const LAS u32x2*)(vb + ql * LDP + kk), va1 = *(const LAS u32x2*)(vb + ql * LDP + kk + 8);
                    u32x2 vb0 = *(const LAS u32x2*)(vb + (32 + ql) * LDP + kk), vb1 = *(const LAS u32x2*)(vb + (32 + ql) * LDP + kk + 8);
                    const bf16x8 af0 = __builtin_bit_cast(bf16x8, (u32x4){va0.x, va0.y, va1.x, va1.y}), af1 = __builtin_bit_cast(bf16x8, (u32x4){vb0.x, vb0.y, vb1.x, vb1.y});
                    O0 = __builtin_amdgcn_mfma_f32_32x32x16_bf16(af0, pf, O0, 0, 0, 0); O1 = __builtin_amdgcn_mfma_f32_32x32x16_bf16(af1, pf, O1, 0, 0, 0);
                }
            if (j + 1 < ntile) ATT_STORE((j + 1) & 1);
            __syncthreads();
        }
#undef ATT_LOAD
#undef ATT_STORE
        { auto rr_ = __builtin_amdgcn_permlane32_swap(__float_as_uint(lsum), __float_as_uint(lsum), false, false); lsum = __uint_as_float(rr_[0]) + __uint_as_float(rr_[1]); }
        const float inv = 1.0f / lsum;
        if (FP8_MRG_L(l)) { unsigned char* op8 = (unsigned char*)gYATT + (size_t)qr * YCS + hq * 64 + 4 * hi;
#pragma unroll
            for (int g4 = 0; g4 < 4; ++g4) { *(unsigned*)(op8 + 8 * g4) = pk4_fp8(O0[4 * g4] * inv, O0[4 * g4 + 1] * inv, O0[4 * g4 + 2] * inv, O0[4 * g4 + 3] * inv);
                *(unsigned*)(op8 + 32 + 8 * g4) = pk4_fp8(O1[4 * g4] * inv, O1[4 * g4 + 1] * inv, O1[4 * g4 + 2] * inv, O1[4 * g4 + 3] * inv); } }
        else {
        bf16* op = gYATT + (size_t)qr * YCS + hq * 64 + 4 * hi;
#pragma unroll
        for (int g4 = 0; g4 < 4; ++g4) {
            u32x2 w0, w1; w0.x = pk2(O0[4 * g4] * inv, O0[4 * g4 + 1] * inv); w0.y = pk2(O0[4 * g4 + 2] * inv, O0[4 * g4 + 3] * inv);
            w1.x = pk2(O1[4 * g4] * inv, O1[4 * g4 + 1] * inv); w1.y = pk2(O1[4 * g4 + 2] * inv, O1[4 * g4 + 3] * inv);
            *(u32x2*)(op + 8 * g4) = w0; *(u32x2*)(op + 32 + 8 * g4) = w1; } }
    }
}

#define WB_PTR(l, off) ((bf16*)(F.ws + WS_WB + (size_t)(l) * WB_LAYER + (off)))
template <int ES, class RowMap>
__device__ __forceinline__ void transpose_item(const float* W, int K, int Nsrc, void* dstv, int ldd, const RowMap& rm, LAS float* scr, int kb, int nb, int lane, float scale = 1.0f) {
    const int k0 = 64 * kb, n0 = 32 * nb;
    { const int n4 = n0 + (lane & 7) * 4;
#pragma unroll
      for (int i = 0; i < 8; ++i) { const int kk = 8 * i + (lane >> 3);
          f32x4 w4 = (f32x4){0.f, 0.f, 0.f, 0.f};
          if (n4 + 3 < Nsrc) w4 = *(const f32x4*)(W + (size_t)(k0 + kk) * Nsrc + n4);
          else { if (n4 < Nsrc) w4.x = W[(size_t)(k0 + kk) * Nsrc + n4]; if (n4 + 1 < Nsrc) w4.y = W[(size_t)(k0 + kk) * Nsrc + n4 + 1]; if (n4 + 2 < Nsrc) w4.z = W[(size_t)(k0 + kk) * Nsrc + n4 + 2]; }
          LAS float* d = scr + kk * 33 + (lane & 7) * 4; d[0] = w4.x * scale; d[1] = w4.y * scale; d[2] = w4.z * scale; d[3] = w4.w * scale; } }
    asm volatile("s_waitcnt lgkmcnt(0)" ::: "memory");
    const int c = lane & 7;
#pragma unroll
    for (int j = 0; j < 4; ++j) { const int n = (lane >> 3) + 8 * j; const LAS float* sp = scr + (8 * c) * 33 + n;
        if constexpr (ES == 2) { u32x4 o; o.x = pk2(sp[0 * 33], sp[1 * 33]); o.y = pk2(sp[2 * 33], sp[3 * 33]); o.z = pk2(sp[4 * 33], sp[5 * 33]); o.w = pk2(sp[6 * 33], sp[7 * 33]);
            *(u32x4*)((bf16*)dstv + (size_t)rm(n0 + n) * ldd + k0 + 8 * c) = o; }
        else { u32x2 o; o.x = pk4_fp8(sp[0 * 33], sp[1 * 33], sp[2 * 33], sp[3 * 33]); o.y = pk4_fp8(sp[4 * 33], sp[5 * 33], sp[6 * 33], sp[7 * 33]);
            *(u32x2*)((unsigned char*)dstv + (size_t)rm(n0 + n) * ldd + k0 + 8 * c) = o; } }
    asm volatile("s_waitcnt lgkmcnt(0)" ::: "memory");
}
struct RmId { __device__ __forceinline__ int operator()(int n) const { return n; } };
struct RmGU { int up; __device__ __forceinline__ int operator()(int n) const { return (n >> 7) * 256 + up * 128 + (n & 127); } };
constexpr int I_WIN = 16 * 224, I_WOUT = 16 * 32, I_WBR = 3 * 8 * 32, I_GU = 65 * 16 * 8, I_DN = 65 * 4 * 32, I_LAYER = I_WIN + I_WOUT + I_WBR + 2 * I_GU + I_DN;
constexpr int CONV_SPLIT = I_LAYER + (I_LAYER * 6) / 10;
__device__ __forceinline__ void ph_convert_weights(Frame& F, int it_lo, int it_hi, int worker, int nworker) {
    LAS float* scr = (LAS float*)(F.lds + F.wave * 16384);
        for (int it = it_lo + worker; it < it_hi; it += nworker) {
        const int l = it / I_LAYER; int r = it % I_LAYER;
        if (r < I_WIN) { if (FP8_WIN_L(l)) transpose_item<1>(i_w_in + (size_t)l * D * DIN, D, DIN, WB_PTR(l, WB_WIN), D, RmId{}, scr, r / 224, r % 224, F.lane, WIN_SCALE); else transpose_item<2>(i_w_in + (size_t)l * D * DIN, D, DIN, WB_PTR(l, WB_WIN), D, RmId{}, scr, r / 224, r % 224, F.lane, 1.0f); continue; } r -= I_WIN;
        if (r < I_WOUT) { if (FP8_MRG_L(l)) transpose_item<1>(i_w_out + (size_t)l * D * D, D, D, WB_PTR(l, WB_WOUT), D, RmId{}, scr, r / 32, r % 32, F.lane, WOUT_SCALE); else transpose_item<2>(i_w_out + (size_t)l * D * D, D, D, WB_PTR(l, WB_WOUT), D, RmId{}, scr, r / 32, r % 32, F.lane); continue; } r -= I_WOUT;
        if (r < I_WBR) { const int b = r / 256, q = r % 256; const float* src = (b == 0 ? i_w_br0 : b == 1 ? i_w_br1 : i_w_br2) + (size_t)l * 512 * D;
            if (FP8_MRG_L(l)) transpose_item<1>(src, 512, D, (unsigned char*)WB_PTR(l, WB_WBR) + (size_t)b * 512, YCS, RmId{}, scr, q / 32, q % 32, F.lane, WBR_SCALE);
            else transpose_item<2>(src, 512, D, WB_PTR(l, WB_WBR) + (size_t)b * 512, YCS, RmId{}, scr, q / 32, q % 32, F.lane); continue; } r -= I_WBR;
        if (r < 2 * I_GU) { const int up = r >= I_GU; if (up) r -= I_GU; const int e = r / 128, q = r % 128;
            const float* src = e < NE ? ((up ? i_ew_up : i_ew_gate) + ((size_t)l * NE + e) * D * EFF) : ((up ? i_sw_up : i_sw_gate) + (size_t)l * D * EFF);
            transpose_item<FP8_MOE1 ? 1 : 2>(src, D, EFF, (unsigned char*)WB_PTR(l, WB_W1) + (size_t)e * 512 * D * (FP8_MOE1 ? 1 : 2), D, RmGU{up}, scr, q / 8, q % 8, F.lane, FP8_MOE1 ? WIN_SCALE : 1.0f); continue; } r -= 2 * I_GU;
        { const int e = r / 128, q = r % 128; const float* src = e < NE ? (i_ew_down + ((size_t)l * NE + e) * EFF * D) : (i_sw_down + (size_t)l * EFF * D);
            if (FP8_MOE2_L(l)) transpose_item<1>(src, EFF, D, (unsigned char*)WB_PTR(l, WB_W2) + (size_t)e * D * EFF, EFF, RmId{}, scr, q / 32, q % 32, F.lane, W2_SCALE);
            else transpose_item<2>(src, EFF, D, WB_PTR(l, WB_W2) + (size_t)e * D * EFF, EFF, RmId{}, scr, q / 32, q % 32, F.lane); }
    }
}
__device__ __forceinline__ void ph_win_mfma(Frame& F, int l) {
    pg8::DenseSched S; S.init(R / 256, PSTR / 256, F.G, (int)blockIdx.x);
    pg8::EpiWin E{gP, gROPE, i_bgate_b + (size_t)l * 3 * D, FP8_WIN_L(l) ? 1.0f / WIN_SCALE : 1.0f};
    if (FP8_WIN_L(l)) pg8::gemm_run<pg8::EpiWin, pg8::DenseSched, 1>(F.lds, F.tid, gA8, WB_PTR(l, WB_WIN), D, D, D, S, E);
    else pg8::gemm_run<pg8::EpiWin, pg8::DenseSched, 2>(F.lds, F.tid, gA, WB_PTR(l, WB_WIN), D, D, D, S, E);
}
__device__ __forceinline__ void ph_merge_mfma(Frame& F, int l) {
    pg8::MergeSched S; S.init(((l == 0) ? R : RL) / 256, D / 256, F.G, (int)blockIdx.x);
    if (FP8_MRG_L(l)) { pg8::EpiMerge3 E{gYMERGE, gH  , gP, (unsigned char*)gA  , 1.0f / WBR_SCALE, 0.f};
        pg8::gemm_run<pg8::EpiMerge3, pg8::MergeSched, 1>(F.lds, F.tid, gYATT, WB_PTR(l, WB_WBR), 512, YCS, YCS, S, E); }
    else { pg8::EpiMerge3 E{gYMERGE, gH, gP, nullptr, 1.0f, 0.f};
        pg8::gemm_run<pg8::EpiMerge3, pg8::MergeSched, 2>(F.lds, F.tid, gYATT, WB_PTR(l, WB_WBR), 512, YCS, YCS, S, E); }
}
__device__ __forceinline__ void ph_wout_mfma(Frame& F, int g, int l) {
    pg8::DenseSched S; S.init(((l == 0) ? R : RL) / 256, D / 256, F.G, (int)blockIdx.x);
    if (FP8_MRG_L(l)) { pg8::EpiWout E{gH  , gMOD + (size_t)l * 17 * 6144, g, 1.0f / (YM_SCALE * WOUT_SCALE)};
        pg8::gemm_run<pg8::EpiWout, pg8::DenseSched, 1>(F.lds, F.tid, gA, WB_PTR(l, WB_WOUT), D, D, D, S, E); }
    else { pg8::EpiWout E{gH, gMOD + (size_t)l * 17 * 6144, g, 1.0f};
        pg8::gemm_run<pg8::EpiWout, pg8::DenseSched, 2>(F.lds, F.tid, gYMERGE, WB_PTR(l, WB_WOUT), D, D, D, S, E); }
}
__device__ __forceinline__ int moe_tiles_to_lds(Frame& F) {
    const int ntile = __builtin_amdgcn_readfirstlane(gNT[0]);
    LAS int* te = (LAS int*)(F.lds + pg8::TILEE_OFF);
    for (int i = F.tid; i < ntile; i += NTHR) te[i] = gTILEE[i];
    asm volatile("s_waitcnt vmcnt(0) lgkmcnt(0)" ::: "memory"); __syncthreads();
    return ntile;
}
__device__ __forceinline__ void ph_moe1_mfma(Frame& F, int l) {
    const int ntile = moe_tiles_to_lds(F);
    pg8::MoeSched<2, true> S; S.init(ntile, F.G, (int)blockIdx.x, (const LAS int*)(F.lds + pg8::TILEE_OFF), gROWTOK);
    pg8::EpiMoe1 E{gH, gROWW, FP8_MOE2_L(l)};
    if (FP8_MOE1) pg8::gemm_run<pg8::EpiMoe1, pg8::MoeSched<2, true>, 1>(F.lds, F.tid, gA8, WB_PTR(l, WB_W1), D, D, D, S, E);
    else pg8::gemm_run<pg8::EpiMoe1, pg8::MoeSched<2, true>, 2>(F.lds, F.tid, gA, WB_PTR(l, WB_W1), D, D, D, S, E);
}
__device__ __forceinline__ void ph_moe2_mfma(Frame& F, int l) {
    const int ntile = moe_tiles_to_lds(F);
    pg8::MoeSched<4, false> S; S.init(ntile, F.G, (int)blockIdx.x, (const LAS int*)(F.lds + pg8::TILEE_OFF), nullptr);
#if YP8
    pg8::EpiF8 E{(unsigned char*)gYP, D, FP8_MOE2_L(l) ? YP_SCALE / (H_SCALE * W2_SCALE) : YP_SCALE};
    if constexpr (FP8_MOE2_MASK == 3) pg8::gemm_run<pg8::EpiF8, pg8::MoeSched<4, false>, 1>(F.lds, F.tid, gH, WB_PTR(l, WB_W2), EFF, EFF, EFF, S, E);
    else if constexpr (FP8_MOE2_MASK == 0) pg8::gemm_run<pg8::EpiF8, pg8::MoeSched<4, false>, 2>(F.lds, F.tid, gH, WB_PTR(l, WB_W2), EFF, EFF, EFF, S, E);
    else { if (FP8_MOE2_L(l)) pg8::gemm_run<pg8::EpiF8, pg8::MoeSched<4, false>, 1>(F.lds, F.tid, gH, WB_PTR(l, WB_W2), EFF, EFF, EFF, S, E);
        else pg8::gemm_run<pg8::EpiF8, pg8::MoeSched<4, false>, 2>(F.lds, F.tid, gH, WB_PTR(l, WB_W2), EFF, EFF, EFF, S, E); }
#else
    pg8::EpiBf E{gYP, D};
    pg8::gemm_run<pg8::EpiBf, pg8::MoeSched<4, false>>(F.lds, F.tid, gH, WB_PTR(l, WB_W2), EFF, EFF, EFF, S, E);
#endif
}

constexpr int NPH = 12, NPHASES = 1 + NG * DEPTH * NPH;
__global__ void __launch_bounds__(NTHR, 2) mk_fwd(Args args) {
    extern __shared__ __attribute__((aligned(16))) unsigned char lds_raw[];
#define FRAME() Frame F; { int t_ = threadIdx.x; asm volatile("" : "+v"(t_)); \
    const __attribute__((address_space(4))) Args* ka_ = (const __attribute__((address_space(4))) Args*)__builtin_amdgcn_kernarg_segment_ptr(); asm volatile("" : "+s"(ka_)); \
    F.lds = (LAS unsigned char*)lds_raw; F.tid = t_; F.lane = t_ & 63; F.wave = __builtin_amdgcn_readfirstlane(t_ >> 6); \
    F.G = gridDim.x; F.gtid = blockIdx.x * NTHR + t_; F.nthr = F.G * NTHR; F.gwave = blockIdx.x * NWAVES + F.wave; F.nwave = F.G * NWAVES; F.a = ka_; F.ws = ka_->ws; }
    LAS unsigned char* const ldsb = (LAS unsigned char*)lds_raw;
    const int lo = args.ph_lo, hi = args.ph_hi;
    volatile LAS unsigned* xbst = (volatile LAS unsigned*)(ldsb + LDS_BYTES - 16);
    if (threadIdx.x < 4) xbst[threadIdx.x] = 0u;
    __syncthreads();
    XcdBarrier bar; bar.bar = ((unsigned*)(args.ws + (WS_CTL))) + CW_BAR; bar.x = 0; bar.st = xbst;
    if (hi - lo > 1) bar = xcd_barrier_post(((unsigned*)(args.ws + (WS_CTL))) + CW_BAR, xbst);
#ifdef ONLYK
#define INK(k) ((k) == ONLYK)
#else
#define INK(k) 1
#endif
#define IN(k) (lo <= (k) && (k) < hi)
#define SEAM(k) do { if ((k) + 1 < hi) xcd_barrier(bar); } while (0)
#define DUPBAR(k) if (DUP == (k)) xcd_barrier(bar)

    if (INK(-1) && IN(0)) { FRAME(); ph_prologue(F); __syncthreads(); ph_convert_weights(F, 0, (F.G > R / 256 * 4) ? I_LAYER : 2 * I_LAYER, F.gwave, F.nwave); SEAM(0); }
    for (int g = 0; g < NG; ++g) {
        { constexpr int l = 0;
            const int b0 = 1 + (g * DEPTH + l) * NPH;
            if (!(b0 + NPH <= lo || b0 >= hi)) {
            if (INK(0) && IN(b0 + 0)) { if (l == 0 && g == 0) { FRAME(); ph_norm1_input(F, g); SEAM(b0 + 0); } }
#if USE_MFMA_WIN
            if (INK(1) && IN(b0 + 1)) { FRAME(); ph_win_mfma(F, l); if (DUP == 1) { xcd_barrier(bar); ph_win_mfma(F, l); } SEAM(b0 + 1); }
#else
            if (INK(1) && IN(b0 + 1)) { FRAME(); ph_win_naive(F, l); SEAM(b0 + 1); }
            if (INK(2) && IN(b0 + 2)) { FRAME(); ph_rope(F); SEAM(b0 + 2); }
#endif
#if USE_MFMA_MLSTM
#if USE_MFMA_ATTN
            if (INK(2) && IN(b0 + 2)) { FRAME(); ph_attn_mfma(F, l); __syncthreads(); ph_mlstm_dc(F, l); ph_conv(F, l); if (DUP == 2) { xcd_barrier(bar); ph_attn_mfma(F, l); } if (DUP == 12) { xcd_barrier(bar); ph_mlstm_dc(F, l); } for (int rep = 0; rep < (DUP == 22 ? 1 : 0); ++rep) { xcd_barrier(bar); ph_conv(F, l); } SEAM(b0 + 2); }
#else
            if (INK(2) && IN(b0 + 2)) { FRAME(); ph_mlstm_dc(F, l); ph_attn_naive(F, l); ph_conv(F, l); SEAM(b0 + 2); }
#endif
            if (INK(3) && IN(b0 + 3)) { FRAME(); ph_mlstm_scan(F); if (DUP == 3) { xcd_barrier(bar); ph_mlstm_scan(F); } SEAM(b0 + 3); }
            if (INK(4) && IN(b0 + 4)) { FRAME(); ph_mlstm_out(F, l); if (DUP == 4) { xcd_barrier(bar); ph_mlstm_out(F, l); } SEAM(b0 + 4); }
#else
            if (INK(3) && IN(b0 + 3)) { FRAME(); ph_mlstm_naive(F, l); ph_attn_naive(F, l); ph_conv(F, l); SEAM(b0 + 3); }
            if (INK(4) && IN(b0 + 4)) { FRAME(); ph_mlstm_final(F, l); SEAM(b0 + 4); }
#endif
#if USE_MFMA_MERGE
            if (INK(5) && IN(b0 + 5)) { FRAME(); ph_merge_mfma(F, l); if (l == 0 && g == 0 && (int)blockIdx.x >= R / 256 * 4 && F.G > R / 256 * 4) ph_convert_weights(F, I_LAYER, CONV_SPLIT, ((int)blockIdx.x - R / 256 * 4) * NWAVES + F.wave, (F.G - R / 256 * 4) * NWAVES); SEAM(b0 + 5); }
#else
            if (INK(5) && IN(b0 + 5)) { FRAME(); ph_merge_naive(F, l); SEAM(b0 + 5); }
#endif
#if USE_MFMA_WOUT
            if (INK(6) && IN(b0 + 6)) { FRAME(); ph_wout_mfma(F, g, l); if (l == 0 && g == 0 && (int)blockIdx.x >= R / 256 * 4 && F.G > R / 256 * 4) ph_convert_weights(F, CONV_SPLIT, 2 * I_LAYER, ((int)blockIdx.x - R / 256 * 4) * NWAVES + F.wave, (F.G - R / 256 * 4) * NWAVES); SEAM(b0 + 6); }
#else
            if (INK(6) && IN(b0 + 6)) { FRAME(); ph_wout_naive(F, g, l); SEAM(b0 + 6); }
#endif
            if (INK(7) && IN(b0 + 7)) { FRAME(); ph_norm2_route(F, g, l); SEAM(b0 + 7); }
            if (INK(8) && IN(b0 + 8)) { FRAME(); ph_scatter(F, g, l); SEAM(b0 + 8); }
#if USE_MFMA_MOE
            if (INK(9) && IN(b0 + 9)) { FRAME(); for (int rep = 0; rep < (DUP == 9 ? 2 : 1); ++rep) { if (rep) xcd_barrier(bar); ph_moe1_mfma(F, l); } SEAM(b0 + 9); }
            if (INK(10) && IN(b0 + 10)) { FRAME(); ph_moe2_mfma(F, l); if (DUP == 10) { xcd_barrier(bar); ph_moe2_mfma(F, l); } if (DUP == 100) { xcd_barrier(bar); xcd_barrier(bar); xcd_barrier(bar); xcd_barrier(bar); } SEAM(b0 + 10); }
#else
            if (INK(9) && IN(b0 + 9)) { FRAME(); ph_moe1_naive(F, l); SEAM(b0 + 9); }
            if (INK(10) && IN(b0 + 10)) { FRAME(); ph_moe2_naive(F, l); SEAM(b0 + 10); }
#endif
            if (INK(11) && IN(b0 + 11)) { FRAME(); ph_combine(F, g, l); if (l == DEPTH - 1 && g + 1 < NG) ph_norm1_input(F, g + 1); SEAM(b0 + 11); }
            }
        }
        { constexpr int l = 1;
            const int b0 = 1 + (g * DEPTH + l) * NPH;
            if (!(b0 + NPH <= lo || b0 >= hi)) {
            if (INK(0) && IN(b0 + 0)) { if (l == 0 && g == 0) { FRAME(); ph_norm1_input(F, g); SEAM(b0 + 0); } }
#if USE_MFMA_WIN
            if (INK(1) && IN(b0 + 1)) { FRAME(); ph_win_mfma(F, l); if (DUP == 1) { xcd_barrier(bar); ph_win_mfma(F, l); } SEAM(b0 + 1); }
#else
            if (INK(1) && IN(b0 + 1)) { FRAME(); ph_win_naive(F, l); SEAM(b0 + 1); }
            if (INK(2) && IN(b0 + 2)) { FRAME(); ph_rope(F); SEAM(b0 + 2); }
#endif
#if USE_MFMA_MLSTM
#if USE_MFMA_ATTN
            if (INK(2) && IN(b0 + 2)) { FRAME(); ph_attn_mfma(F, l); __syncthreads(); ph_mlstm_dc(F, l); ph_conv(F, l); if (DUP == 2) { xcd_barrier(bar); ph_attn_mfma(F, l); } if (DUP == 12) { xcd_barrier(bar); ph_mlstm_dc(F, l); } for (int rep = 0; rep < (DUP == 22 ? 1 : 0); ++rep) { xcd_barrier(bar); ph_conv(F, l); } SEAM(b0 + 2); }
#else
            if (INK(2) && IN(b0 + 2)) { FRAME(); ph_mlstm_dc(F, l); ph_attn_naive(F, l); ph_conv(F, l); SEAM(b0 + 2); }
#endif
            if (INK(3) && IN(b0 + 3)) { FRAME(); ph_mlstm_scan(F); if (DUP == 3) { xcd_barrier(bar); ph_mlstm_scan(F); } SEAM(b0 + 3); }
            if (INK(4) && IN(b0 + 4)) { FRAME(); ph_mlstm_out(F, l); if (DUP == 4) { xcd_barrier(bar); ph_mlstm_out(F, l); } SEAM(b0 + 4); }
#else
            if (INK(3) && IN(b0 + 3)) { FRAME(); ph_mlstm_naive(F, l); ph_attn_naive(F, l); ph_conv(F, l); SEAM(b0 + 3); }
            if (INK(4) && IN(b0 + 4)) { FRAME(); ph_mlstm_final(F, l); SEAM(b0 + 4); }
#endif
#if USE_MFMA_MERGE
            if (INK(5) && IN(b0 + 5)) { FRAME(); ph_merge_mfma(F, l); if (l == 0 && g == 0 && (int)blockIdx.x >= R / 256 * 4 && F.G > R / 256 * 4) ph_convert_weights(F, I_LAYER, CONV_SPLIT, ((int)blockIdx.x - R / 256 * 4) * NWAVES + F.wave, (F.G - R / 256 * 4) * NWAVES); SEAM(b0 + 5); }
#else
            if (INK(5) && IN(b0 + 5)) { FRAME(); ph_merge_naive(F, l); SEAM(b0 + 5); }
#endif
#if USE_MFMA_WOUT
            if (INK(6) && IN(b0 + 6)) { FRAME(); ph_wout_mfma(F, g, l); if (l == 0 && g == 0 && (int)blockIdx.x >= R / 256 * 4 && F.G > R / 256 * 4) ph_convert_weights(F, CONV_SPLIT, 2 * I_LAYER, ((int)blockIdx.x - R / 256 * 4) * NWAVES + F.wave, (F.G - R / 256 * 4) * NWAVES); SEAM(b0 + 6); }
#else
            if (INK(6) && IN(b0 + 6)) { FRAME(); ph_wout_naive(F, g, l); SEAM(b0 + 6); }
#endif
            if (INK(7) && IN(b0 + 7)) { FRAME(); ph_norm2_route(F, g, l); SEAM(b0 + 7); }
            if (INK(8) && IN(b0 + 8)) { FRAME(); ph_scatter(F, g, l); SEAM(b0 + 8); }
#if USE_MFMA_MOE
            if (INK(9) && IN(b0 + 9)) { FRAME(); for (int rep = 0; rep < (DUP == 9 ? 2 : 1); ++rep) { if (rep) xcd_barrier(bar); ph_moe1_mfma(F, l); } SEAM(b0 + 9); }
            if (INK(10) && IN(b0 + 10)) { FRAME(); ph_moe2_mfma(F, l); if (DUP == 10) { xcd_barrier(bar); ph_moe2_mfma(F, l); } if (DUP == 100) { xcd_barrier(bar); xcd_barrier(bar); xcd_barrier(bar); xcd_barrier(bar); } SEAM(b0 + 10); }
#else
            if (INK(9) && IN(b0 + 9)) { FRAME(); ph_moe1_naive(F, l); SEAM(b0 + 9); }
            if (INK(10) && IN(b0 + 10)) { FRAME(); ph_moe2_naive(F, l); SEAM(b0 + 10); }
#endif
            if (INK(11) && IN(b0 + 11)) { FRAME(); ph_combine(F, g, l); if (l == DEPTH - 1 && g + 1 < NG) ph_norm1_input(F, g + 1); SEAM(b0 + 11); }
            }
        }
    }
#undef IN
#undef SEAM
}

extern "C" void kernel_launch(void* const* d_in, const int* in_sizes, int n_in, void* d_out, int out_size, void* d_ws, size_t ws_size, hipStream_t stream) {
    static int grid = 0;
    if (grid == 0) {
        if (n_in != 27 || out_size != BATCH * SEQ * D || ws_size < WS_END) { fprintf(stderr, "kernel_launch: unexpected shapes (n_in %d out %d ws %zu need %zu)\n", n_in, out_size, ws_size, (size_t)WS_END); grid = -1; return; }
        int dev = 0, cus = 0, per_cu = 0;
        if (hipGetDevice(&dev) != hipSuccess || hipDeviceGetAttribute(&cus, hipDeviceAttributeMultiprocessorCount, dev) != hipSuccess) { grid = -1; return; }
        if (hipFuncSetAttribute((const void*)mk_fwd, hipFuncAttributeMaxDynamicSharedMemorySize, LDS_BYTES) != hipSuccess) { fprintf(stderr, "kernel_launch: hipFuncSetAttribute failed\n"); grid = -1; return; }
        if (hipOccupancyMaxActiveBlocksPerMultiprocessor(&per_cu, (const void*)mk_fwd, NTHR, LDS_BYTES) != hipSuccess || per_cu < 1) { fprintf(stderr, "kernel_launch: occupancy query says %d\n", per_cu); }
        (void)hipGetLastError();
        grid = cus;
    }
    if (grid < 0) return;
    if (hipMemsetAsync((char*)d_ws + WS_CTL, 0, CTL_ZERO_BYTES, stream) != hipSuccess) return;
    Args a{};
    for (int i = 0; i < 27; ++i) a.in[i] = (const float*)d_in[i];
    a.out = (float*)d_out; a.ws = (unsigned char*)d_ws;
#if MK_ONE_LAUNCH
    a.ph_lo = 0; a.ph_hi = NPHASES;
    hipLaunchKernelGGL(mk_fwd, dim3(grid), dim3(NTHR), LDS_BYTES, stream, a);
#else
    for (int p = 0; p < NPHASES; ++p) {
        const int k = (p == 0) ? -1 : (p - 1) % NPH, l = (p == 0) ? 0 : ((p - 1) / NPH) % DEPTH;
        if (k == 0 && l != 0) continue;
        a.ph_lo = p; a.ph_hi = p + 1;
        hipLaunchKernelGGL(mk_fwd, dim3(grid), dim3(NTHR), LDS_BYTES, stream, a);
    }
#endif
}
```

```cpp
#include <hip/hip_runtime.h>
#include <cstdio>
#include <cstdint>

#ifndef DUP
#define DUP -99
#endif
#ifndef FP8_MOE2_MASK
#define FP8_MOE2_MASK 3
#endif
#define FP8_MOE2_L(l) (((FP8_MOE2_MASK) >> (l)) & 1)
#ifndef FP8_MRG_MASK
#define FP8_MRG_MASK 3
#endif
#define FP8_MRG_L(l) (((FP8_MRG_MASK) >> (l)) & 1)
#ifndef FP8_WIN_MASK
#define FP8_WIN_MASK 3
#endif
#define FP8_WIN_L(l) (((FP8_WIN_MASK) >> (l)) & 1)
#ifndef FP8_MOE1
#define FP8_MOE1 1
#endif
#ifndef YP8
#define YP8 1
#endif
#ifndef MRG_NB
#define MRG_NB 1
#endif
#ifndef MK_ONE_LAUNCH
#define MK_ONE_LAUNCH 1
#endif
#ifndef USE_MFMA_WIN
#define USE_MFMA_WIN 1
#endif
#ifndef USE_MFMA_WOUT
#define USE_MFMA_WOUT 1
#endif
#ifndef USE_MFMA_MOE
#define USE_MFMA_MOE 1
#endif
#ifndef USE_MFMA_MERGE
#define USE_MFMA_MERGE 1
#endif
#ifndef USE_MFMA_MLSTM
#define USE_MFMA_MLSTM 1
#endif
#ifndef USE_MFMA_ATTN
#define USE_MFMA_ATTN 1
#endif

#define GAS __attribute__((address_space(1)))
#define LAS __attribute__((address_space(3)))
typedef unsigned short bf16;
typedef unsigned u32x4 __attribute__((ext_vector_type(4)));
typedef unsigned u32x2 __attribute__((ext_vector_type(2)));
typedef float f32x4 __attribute__((ext_vector_type(4)));
typedef short bf16x8 __attribute__((ext_vector_type(8)));

constexpr int D = 1024, BATCH = 16, SEQ = 2048, CTXL = 256, DEPTH = 2, DIN = 6928, PSTR = 7168;
constexpr int NG = 4, GB = BATCH / NG, RL = GB * SEQ, RC = GB * CTXL, R = RL + RC;
constexpr int OQA = 0, OKA = 512, OVA = 640, OQM = 768, OKM = 1024, OVM = 1280, OOM = 1792, OGM = 2304, OBC = 2320, OCC = 2832, OXC = 3344, OBG = 3856;
constexpr int NE = 64, TOPK = 8, EFF = 256;
constexpr int RCAP = BATCH / 4 * (SEQ + CTXL);
constexpr float WBR_SCALE = 16.0f, YM_SCALE = 8.0f, WOUT_SCALE = 32.0f;
constexpr float H_SCALE = 8.0f, W2_SCALE = 16.0f;
constexpr float YP_SCALE = 64.0f;
constexpr float WIN_SCALE = 32.0f;
constexpr int YCS = 1536;
constexpr int MAXT = (R * TOPK) / 256 + NE;
constexpr int NPMAX = MAXT * 256;
constexpr float EPS = 1e-6f;
constexpr int NTHR = 512, NWAVES = 8;

constexpr size_t MiB = 1u << 20;
constexpr size_t WS_CTL = 0, CTL_ZERO_BYTES = 1 * MiB;
constexpr size_t WS_MOD = 1 * MiB;
constexpr size_t WS_ROPE = 2 * MiB;
constexpr size_t WS_ROUTE = 3 * MiB;
constexpr size_t WS_X = 6 * MiB;
constexpr size_t WS_A = WS_X + 36 * MiB;
constexpr size_t WS_P = WS_A + 18 * MiB;
constexpr size_t WS_YATT = WS_P + 126 * MiB;
constexpr size_t WS_YMLS = WS_YATT + 9 * MiB;
constexpr size_t WS_YCONV = WS_YMLS + 9 * MiB;
constexpr size_t WS_HDIR = WS_YCONV + 9 * MiB;
constexpr size_t WS_YP = WS_P;
constexpr size_t WS_YMERGE = 256 * MiB;
constexpr size_t WS_H = WS_YMERGE + 18 * MiB;
constexpr size_t WS_YS = WS_H;
constexpr size_t WS_WB = WS_H + 49 * MiB;
constexpr size_t WB_WIN = 0, WB_WOUT = 14 * MiB, WB_WBR = 16 * MiB, WB_W1 = 19 * MiB, WB_W2 = 84 * MiB, WB_LAYER = 117 * MiB;
constexpr size_t WS_CIN = WS_WB + 2 * WB_LAYER;
constexpr size_t WS_A8 = WS_CIN + 18 * MiB;
constexpr size_t WS_END = WS_A8 + 9 * MiB;
static_assert(WS_P + (size_t)(NPMAX + R) * 1024 * 2 <= WS_YMERGE, "Yp overlay");
static_assert((size_t)(NPMAX + R) * 256 * 2 <= 49 * MiB, "H");
static_assert((size_t)65 * 512 * 1024 * 2 <= WB_W2 - WB_W1 && WB_W2 + (size_t)65 * 1024 * 256 * 2 <= WB_LAYER, "weights");
constexpr int CW_BAR = 4096;
constexpr int CW_CNT = 16384;
constexpr size_t RT_EIDX = 0, RT_EW = RT_EIDX + (size_t)R * 8 * 4, RT_SPOS = RT_EW + (size_t)R * 8 * 4, RT_ROWTOK = RT_SPOS + (size_t)R * 8 * 4,
                 RT_ROWW = RT_ROWTOK + (size_t)(NPMAX + R) * 4, RT_TILEE = RT_ROWW + (size_t)(NPMAX + R) * 4, RT_NT = RT_TILEE + 512 * 4, RT_END = RT_NT + 256;
static_assert(RT_END <= 3 * MiB, "route tables");

constexpr int LDS_BYTES = 147456;

typedef GAS unsigned gu32;
#define RLX_AGENT __ATOMIC_RELAXED, __HIP_MEMORY_SCOPE_AGENT
__device__ __forceinline__ float bf2f(unsigned short b) { return __uint_as_float(((unsigned)b) << 16); }
typedef float f32x2v __attribute__((ext_vector_type(2)));
typedef __bf16 bf16x2v __attribute__((ext_vector_type(2)));
__device__ __forceinline__ unsigned pk2(float lo, float hi) { const f32x2v v = {lo, hi}; return __builtin_bit_cast(unsigned, __builtin_convertvector(v, bf16x2v)); }
__device__ __forceinline__ unsigned f2bf(float f) { return pk2(f, f) & 0xffffu; }
__device__ __forceinline__ float blo(unsigned w) { return __uint_as_float(w << 16); }
__device__ __forceinline__ float bhi(unsigned w) { return __uint_as_float(w & 0xffff0000u); }
__device__ __forceinline__ float clamp_e4m3(float x) { return __builtin_amdgcn_fmed3f(x, -448.0f, 448.0f); }
__device__ __forceinline__ unsigned pk4_fp8(float a, float b, float c, float d) {
    unsigned w = __builtin_amdgcn_cvt_pk_fp8_f32(clamp_e4m3(a), clamp_e4m3(b), 0u, false); return __builtin_amdgcn_cvt_pk_fp8_f32(clamp_e4m3(c), clamp_e4m3(d), w, true); }
__device__ __forceinline__ float sigmoidf_(float x) { return 1.0f / (1.0f + __expf(-x)); }
template <int CTRL, int ROWMASK> __device__ __forceinline__ float dpp_f(float old, float v) {
    return __int_as_float(__builtin_amdgcn_update_dpp(__float_as_int(old), __float_as_int(v), CTRL, ROWMASK, 0xF, false)); }
__device__ __forceinline__ float wave_sum(float v) {
    v += dpp_f<0xB1, 0xF>(0.f, v); v += dpp_f<0x4E, 0xF>(0.f, v); v += dpp_f<0x141, 0xF>(0.f, v); v += dpp_f<0x140, 0xF>(0.f, v);
    v += dpp_f<0x142, 0xA>(0.f, v); v += dpp_f<0x143, 0xC>(0.f, v);
    return __int_as_float(__builtin_amdgcn_readlane(__float_as_int(v), 63));
}
__device__ __forceinline__ float wave_max(float v) {
    v = fmaxf(v, dpp_f<0xB1, 0xF>(v, v)); v = fmaxf(v, dpp_f<0x4E, 0xF>(v, v)); v = fmaxf(v, dpp_f<0x141, 0xF>(v, v)); v = fmaxf(v, dpp_f<0x140, 0xF>(v, v));
    v = fmaxf(v, dpp_f<0x142, 0xA>(v, v)); v = fmaxf(v, dpp_f<0x143, 0xC>(v, v));
    return __int_as_float(__builtin_amdgcn_readlane(__float_as_int(v), 63));
}
__device__ __forceinline__ float oct_max(float v) {
    v = fmaxf(v, dpp_f<0xB1, 0xF>(v, v)); v = fmaxf(v, dpp_f<0x4E, 0xF>(v, v)); return fmaxf(v, dpp_f<0x141, 0xF>(v, v)); }

#define XB_TMO      128
#define XB_XCNT(j)  (256  + 64 * (j))
#define XB_XSUB(j)  (1280 + 64 * (j))
#define XB_XGEN(j)  (2304 + 64 * (j))
#define XB_TOP      3328
#define XB_TOPGEN   3392
#define XCD_BAR_WORDS 3456
#define XB_SPIN_CAP (1u << 22)
__device__ __forceinline__ unsigned xb_ld(unsigned* p)              { return __hip_atomic_load(p, __ATOMIC_RELAXED, __HIP_MEMORY_SCOPE_AGENT); }
__device__ __forceinline__ unsigned xb_add(unsigned* p, unsigned v) { return __hip_atomic_fetch_add(p, v, __ATOMIC_RELAXED, __HIP_MEMORY_SCOPE_AGENT); }
__device__ __forceinline__ unsigned xb_xcc_id() { return (unsigned)__builtin_amdgcn_s_getreg((3 << 11) | 20) & 0xFu; }
#define XB_SPIN(cond, bar) do { unsigned _sp = 0; while (cond) { __builtin_amdgcn_s_sleep(1); \
    if ((++_sp & 255u) == 0u) { if (xb_ld(&(bar)[XB_TMO])) break; if (_sp > XB_SPIN_CAP) { atomicAdd(&(bar)[XB_TMO], 1u); break; } } } } while (0)
struct XcdBarrier { unsigned* bar; unsigned x; volatile LAS unsigned* st; };
__device__ __forceinline__ XcdBarrier xcd_barrier_post(unsigned* bar, volatile LAS unsigned* st) {
    XcdBarrier b; b.bar = bar; b.x = xb_xcc_id(); b.st = st;
    if (threadIdx.x == 0) (void)xb_add(&bar[XB_XCNT(b.x)], 1u);
    return b;
}
__device__ __forceinline__ void xcd_barrier_complete(unsigned* bar, unsigned x, unsigned& nloc, unsigned& nx) {
    const unsigned G = gridDim.x * gridDim.y * gridDim.z;
    unsigned sum, cnt, mine, sp = 0u;
    for (;;) {
        sum = 0u; cnt = 0u; mine = 0u;
#pragma unroll
        for (unsigned j = 0; j < 16; ++j) { const unsigned c = xb_ld(&bar[XB_XCNT(j)]); sum += c; cnt += (c > 0u) ? 1u : 0u; mine = (j == x) ? c : mine; }
        if (sum == G) break;
        __builtin_amdgcn_s_sleep(1);
        if ((++sp & 255u) == 0u) { if (xb_ld(&bar[XB_TMO])) break; if (sp > XB_SPIN_CAP) { atomicAdd(&bar[XB_TMO], 1u); break; } }
    }
    nloc = mine > 0u ? mine : 1u; nx = cnt > 0u ? cnt : 1u;
}
__device__ __forceinline__ void xcd_barrier(const XcdBarrier& b) {
    asm volatile("s_waitcnt vmcnt(0)" ::: "memory");
    __syncthreads();
    if (threadIdx.x == 0) {
        unsigned* bar = b.bar;
        __builtin_amdgcn_s_waitcnt(0);
        unsigned nloc = b.st[0], nx = b.st[1];
        if (nloc == 0u) { xcd_barrier_complete(bar, b.x, nloc, nx); b.st[0] = nloc; b.st[1] = nx; }
        const unsigned old = xb_add(&bar[XB_XSUB(b.x)], 1u);
        const unsigned gen = old / nloc;
        if (old + 1u == (gen + 1u) * nloc) {
            __builtin_amdgcn_fence(__ATOMIC_RELEASE, "agent");
            asm volatile("s_waitcnt vmcnt(0)" ::: "memory");
            const unsigned og = xb_add(&bar[XB_TOP], 1u);
            const unsigned tg = og / nx;
            if (og + 1u == (tg + 1u) * nx) xb_add(&bar[XB_TOPGEN], 1u);
            else XB_SPIN(xb_ld(&bar[XB_TOPGEN]) == tg, bar);
            __builtin_amdgcn_fence(__ATOMIC_ACQUIRE, "agent");
            xb_add(&bar[XB_XGEN(b.x)], 1u);
            asm volatile("s_waitcnt vmcnt(0)" ::: "memory");
        } else {
            XB_SPIN(xb_ld(&bar[XB_XGEN(b.x)]) == gen, bar);
            __builtin_amdgcn_fence(__ATOMIC_ACQUIRE, "agent");
            asm volatile("s_waitcnt vmcnt(0)" ::: "memory");
        }
    }
    __syncthreads();
}

namespace pg8 {
constexpr int BM = 256, BK = 64, HALF = 128, HTB = HALF * BK * 2, STAGE_BYTES = 8 * HTB, NXCD = 8, WGM = 8;
constexpr int IDX_OFF = STAGE_BYTES, TILEE_OFF = STAGE_BYTES + 2048;
__device__ __forceinline__ int lds_byte(int r, int c) { const int st = (r >> 4) * 2 + (c >> 5), rr = r & 15, cc = c & 31, ob = rr * 64 + cc * 2; return st * 1024 + (ob ^ (((ob >> 9) & 1) << 5)); }
__device__ __forceinline__ void stage_rc(int b, int& R_, int& C_) { const int st = b / 1024, sb = b % 1024, swz = sb ^ (((sb >> 9) & 1) << 5); R_ = (st >> 1) * 16 + swz / 64; C_ = (st & 1) * 32 + (swz % 64) / 2; }
__device__ __forceinline__ int perm32(int rho) { const int n = rho >> 4, i = rho & 15; return 8 * (i >> 2) + 4 * n + (i & 3); }
__device__ __forceinline__ unsigned cvt_pk_bf16(float lo, float hi) { return pk2(lo, hi); }
struct Unit { int pm, pn, pb, kofs; };
__device__ __forceinline__ int xcd_chunk(int L, int nwg) { const int q = nwg / NXCD, r = nwg % NXCD, xcd = L % NXCD, off = L / NXCD; return (xcd < r ? xcd * (q + 1) : r * (q + 1) + (xcd - r) * q) + off; }
struct DenseSched {
    static constexpr bool GATHER = false;
    int nM, nN, nwg, G, c;
    __device__ __forceinline__ void init(int nM_, int nN_, int G_, int c_) { nM = nM_; nN = nN_; nwg = nM * nN; G = G_; c = c_; }
    __device__ __forceinline__ bool next(int i, Unit& u) const {
        const long L = (long)i * G + c; if (L >= nwg) return false;
        const int wgid = xcd_chunk((int)L, nwg);
        const int nig = WGM * nN, gid = wgid / nig, fm = gid * WGM, gsz = (nM - fm) < WGM ? (nM - fm) : WGM;
        u.pm = fm + ((wgid % nig) % gsz); u.pn = (wgid % nig) / gsz; u.pb = u.pn; u.kofs = 0; return true;
    }
    __device__ __forceinline__ const int* idx_ptr(const Unit&) const { return nullptr; }
};
struct WinSched {
    static constexpr bool GATHER = false;
    DenseSched d;
    __device__ __forceinline__ void init(int nM_, int nN_, int G_, int c_) { d.init(nM_, nN_, G_, c_); }
    __device__ __forceinline__ bool next(int i, Unit& u) const {
        if (!d.next(i, u)) return false;
        const int a = u.pn >> 2, b = u.pn & 3, k = ((a >> 1) << 2) + b;
        u.pn = (a & 1) ? 15 + k : (k < 15 ? k : 27); u.pb = u.pn; return true;
    }
    __device__ __forceinline__ const int* idx_ptr(const Unit&) const { return nullptr; }
};
struct MergeSched {
    static constexpr bool GATHER = false;
    int nM, nN, nwg, G, c;
    __device__ __forceinline__ void init(int nM_, int nN_, int G_, int c_) { nM = nM_; nN = nN_; nwg = nM * nN; G = G_; c = c_; }
    __device__ __forceinline__ bool next(int i, Unit& u) const {
        const int q = i / 3, sg = i - 3 * q;
        const long L = (long)q * G + c; if (L >= nwg) return false;
        const int wgid = xcd_chunk((int)L, nwg);
        const int nig = WGM * nN, gid = wgid / nig, fm = gid * WGM, gsz = (nM - fm) < WGM ? (nM - fm) : WGM;
        u.pm = fm + ((wgid % nig) % gsz); u.pn = (wgid % nig) / gsz; u.pb = u.pn; u.kofs = sg * 512; return true;
    }
    __device__ __forceinline__ const int* idx_ptr(const Unit&) const { return nullptr; }
};
template <int NPN, bool GATHER_> struct MoeSched {
    static constexpr bool GATHER = GATHER_;
    int nwg, G, c, base, stride; const LAS int* tilee; const LAS int* toff; const int* rowtok;
    __device__ __forceinline__ void init(int ntile, int G_, int c_, const LAS int* te, const int* rt) {
        nwg = ntile * NPN; G = G_; c = c_; tilee = te; toff = te + 512; rowtok = rt;
        if ((G & 7) == 0) { const int q = nwg / NXCD, r = nwg % NXCD, xcd = c & 7; base = (xcd < r ? xcd * (q + 1) : r * (q + 1) + (xcd - r) * q) + (c >> 3); stride = G >> 3; }
        else { base = c; stride = G; }
    }
    __device__ __forceinline__ bool next(int i, Unit& u) const {
        if (i * G + c >= nwg) return false;
        const int wgid = base + i * stride;
        u.pm = wgid / NPN; u.pn = wgid % NPN; u.pb = __builtin_amdgcn_readfirstlane(tilee[u.pm]) * NPN + u.pn; u.kofs = 0; return true;
    }
    __device__ __forceinline__ const int* idx_ptr(const Unit& u) const { const int e = __builtin_amdgcn_readfirstlane(tilee[u.pm]); const int j = u.pm - __builtin_amdgcn_readfirstlane(toff[e]); return rowtok + (size_t)e * RCAP + j * 256; }
};

typedef int i32x8 __attribute__((ext_vector_type(8)));
template <class Epi, class Sched, int ES = 2, int NB = 2>
__device__ __forceinline__ void gemm_run(LAS unsigned char* lds, const int tid  , const void* Ab, const void* Btb, const int K  , const int lda, const int ldb  , const Sched& S, const Epi& E) {
    const int wid = __builtin_amdgcn_readfirstlane(tid >> 6), lane = tid & 63, wr = wid >> 2, wc = wid & 3, fr = lane & 15, fq = lane >> 4;
    int nt = (K * ES) / (BK * 2); asm volatile("" : "+s"(nt));
    unsigned voffB[2];
#pragma unroll
    for (int i = 0; i < 2; ++i) { int R_, C_; stage_rc(tid * 16 + i * 8192, R_, C_);
        const int rho_ = R_ & 31, Rb = ((int)Epi::PERM == 2) ? ((R_ >> 5) * 64 + 16 * ((rho_ & 15) >> 2) + 4 * (rho_ >> 4) + (rho_ & 3)) : (Epi::PERM ? ((R_ & ~31) + perm32(rho_)) : R_);
        voffB[i] = (unsigned)Rb * (unsigned)(ldb * ES) + (unsigned)C_ * 2u; }
    const unsigned rowb = (unsigned)(lda * ES);
    const size_t kstep = (size_t)(BK * 2), hstep = (size_t)(((int)Epi::PERM == 2) ? 8 : HALF) * ldb * ES, tstep = (size_t)NB * HALF * ldb * ES;
    const unsigned ldsw = (unsigned)wid * 1024u;
    const int aoff = lds_byte(wr * 64 + fr, fq * 8), boff = lds_byte(wc * 32 + fr, fq * 8);
    const int ob8 = fr * 64 + (fq & 1) * 32, sw8 = ob8 ^ (((ob8 >> 9) & 1) << 5);
    const int aoff8 = (wr * 8 + (fq >> 1)) * 1024 + sw8, boff8 = (wc * 4 + (fq >> 1)) * 1024 + sw8;
    LAS int* idxb = (LAS int*)(lds + IDX_OFF);
#define PG8_SA(b, h) (((b) * 2 + (h)) * HTB)
#define PG8_SB(b, h) ((4 + (b) * 2 + (h)) * HTB)
#define PG8_STAGE(bufoff, gbase, voff) do { _Pragma("unroll") for (int _i = 0; _i < 2; ++_i) \
        __builtin_amdgcn_global_load_lds((const unsigned*)((const char*)(gbase) + (voff)[_i]), (LAS unsigned*)(lds + (bufoff) + ldsw + _i * 8192), 16, 0, 0); } while (0)
#define PG8_LDA(dst, b, h) do { if constexpr (ES == 2) { _Pragma("unroll") for (int m = 0; m < 4; ++m) _Pragma("unroll") for (int k = 0; k < 2; ++k) dst[m][k] = *(const LAS bf16x8*)(lds + PG8_SA(b, h) + aoff + m * 2048 + k * 1024); } \
        else { _Pragma("unroll") for (int m = 0; m < 4; ++m) { const u32x4 lo_ = *(const LAS u32x4*)(lds + PG8_SA(b, h) + aoff8 + m * 2048), hi_ = *(const LAS u32x4*)(lds + PG8_SA(b, h) + aoff8 + m * 2048 + 16); \
            dst##8[m] = (i32x8){(int)lo_.x, (int)lo_.y, (int)lo_.z, (int)lo_.w, (int)hi_.x, (int)hi_.y, (int)hi_.z, (int)hi_.w}; } } } while (0)
#define PG8_LDB(dst, b, h) do { if constexpr (ES == 2) { _Pragma("unroll") for (int n = 0; n < 2; ++n) _Pragma("unroll") for (int k = 0; k < 2; ++k) dst[n][k] = *(const LAS bf16x8*)(lds + PG8_SB(b, h) + boff + n * 2048 + k * 1024); } \
        else { _Pragma("unroll") for (int n = 0; n < 2; ++n) { const u32x4 lo_ = *(const LAS u32x4*)(lds + PG8_SB(b, h) + boff8 + n * 2048), hi_ = *(const LAS u32x4*)(lds + PG8_SB(b, h) + boff8 + n * 2048 + 16); \
            dst##8[n] = (i32x8){(int)lo_.x, (int)lo_.y, (int)lo_.z, (int)lo_.w, (int)hi_.x, (int)hi_.y, (int)hi_.z, (int)hi_.w}; } } } while (0)
#define PG8_MMA(ai, bj, At, Bt) do { __builtin_amdgcn_s_setprio(1); if constexpr (ES == 2) { _Pragma("unroll") for (int m = 0; m < 4; ++m) _Pragma("unroll") for (int n = 0; n < 2; ++n) _Pragma("unroll") for (int k = 0; k < 2; ++k) \
        acc[ai][bj][m][n] = __builtin_amdgcn_mfma_f32_16x16x32_bf16(Bt[n][k], At[m][k], acc[ai][bj][m][n], 0, 0, 0); } \
        else { _Pragma("unroll") for (int m = 0; m < 4; ++m) _Pragma("unroll") for (int n = 0; n < 2; ++n) \
        acc[ai][bj][m][n] = __builtin_amdgcn_mfma_scale_f32_16x16x128_f8f6f4(Bt##8[n], At##8[m], acc[ai][bj][m][n], 0, 0, 0, 0x7F7F7F7F, 0, 0x7F7F7F7F); } \
        __builtin_amdgcn_s_setprio(0); } while (0)
#define PG8_WAIT_V(n) asm volatile("s_waitcnt vmcnt(" #n ")" ::: "memory")
#define PG8_WAIT_L(n) asm volatile("s_waitcnt lgkmcnt(" #n ")" ::: "memory")
#define PG8_WAIT_LOOP do { if constexpr (NB == 2) PG8_WAIT_V(8); else PG8_WAIT_V(6); } while (0)
#define PG8_BAR __builtin_amdgcn_s_barrier()
#define PG8_SCHED __builtin_amdgcn_sched_barrier(0)
#define PG8_ROWOFFS_H(v, u, slot, h_) do { _Pragma("unroll") for (int i_ = 0; i_ < 2; ++i_) { int R_, C_; stage_rc(tid * 16 + i_ * 8192, R_, C_); \
        int row_ = Sched::GATHER ? idxb[(slot) * 256 + (h_) * HALF + R_] : ((u) * BM + (h_) * HALF + R_); if (Sched::GATHER) row_ = ((unsigned)row_ < (unsigned)RCAP) ? row_ : 0; v[h_][i_] = (unsigned)row_ * rowb + (unsigned)C_ * 2u; } } while (0)
    int c_pm, c_pn, c_pb, c_ko, n_pm = 0, n_pn = 0, n_pb = 0, n_ko = 0; int ui = 0;
    { Unit t_; if (!S.next(0, t_)) return; c_pm = t_.pm; c_pn = t_.pn; c_pb = t_.pb; c_ko = t_.kofs; }
#define CUR_U (Unit{c_pm, c_pn, c_pb, c_ko})
#define NXT_U (Unit{n_pm, n_pn, n_pb, n_ko})
    f32x4 acc[2][2][4][2];
#pragma unroll
    for (int a = 0; a < 2; ++a)
#pragma unroll
        for (int b = 0; b < 2; ++b)
#pragma unroll
            for (int m = 0; m < 4; ++m)
#pragma unroll
                for (int n = 0; n < 2; ++n) acc[a][b][m][n] = (f32x4){0.f, 0.f, 0.f, 0.f};
    bf16x8 At[4][2], B0[2][2], B1[2][2]; i32x8 At8[4], B08[2], B18[2];
    unsigned vAc[2][2];
    const char* Ak = (const char*)Ab + (size_t)c_ko * ES;
    const char* cB = (const char*)Btb + (size_t)c_pb * tstep + (size_t)c_ko * ES;
    if constexpr (Sched::GATHER) {
        if (wid == 0) __builtin_amdgcn_global_load_lds((const unsigned*)(S.idx_ptr(CUR_U) + lane * 4), (LAS unsigned*)(idxb), 16, 0, 0);
        PG8_WAIT_V(0); PG8_BAR;
    }
    PG8_ROWOFFS_H(vAc, c_pm, 0, 0); PG8_ROWOFFS_H(vAc, c_pm, 0, 1);
    PG8_STAGE(PG8_SB(0, 0), cB, voffB); if constexpr (NB == 2) PG8_STAGE(PG8_SB(0, 1), cB + hstep, voffB); PG8_STAGE(PG8_SA(0, 0), Ak, vAc[0]); PG8_STAGE(PG8_SA(0, 1), Ak, vAc[1]);
    if (wr == 1) PG8_BAR;
    PG8_WAIT_V(2); PG8_BAR;
    PG8_STAGE(PG8_SB(1, 0), cB + kstep, voffB); PG8_STAGE(PG8_SA(1, 0), Ak + kstep, vAc[0]); if constexpr (NB == 2) PG8_STAGE(PG8_SB(1, 1), cB + hstep + kstep, voffB);
    if constexpr (NB == 2) PG8_WAIT_V(6); else PG8_WAIT_V(4);
    PG8_BAR;
    for (;;) {
        bool has_next; { Unit t_; has_next = S.next(ui + 1, t_); if (has_next) { n_pm = t_.pm; n_pn = t_.pn; n_pb = t_.pb; n_ko = t_.kofs; } }
        const char* nB = has_next ? (const char*)Btb + (size_t)n_pb * tstep + (size_t)n_ko * ES : cB;
        const char* nAk = has_next ? (const char*)Ab + (size_t)n_ko * ES : Ak;
#pragma unroll 1
        for (int t = 0; t < nt; t += 2) {
            const bool last = (t == nt - 2);
            if constexpr (Sched::GATHER) { if (t == 0 && has_next && wid == 0)
                __builtin_amdgcn_global_load_lds((const unsigned*)(S.idx_ptr(NXT_U) + lane * 4), (LAS unsigned*)(idxb + ((ui + 1) & 1) * 256), 16, 0, 0); }
            if constexpr (Epi::HOOK) { constexpr int SEGT = (ES == 2) ? 8 : 4; if (t == SEGT || t == 2 * SEGT) E.hook(acc, CUR_U, t / SEGT, wr, wc, fr, fq); }
            const bool roll = last && has_next;
            if (roll) PG8_ROWOFFS_H(vAc, n_pm, (ui + 1) & 1, 0);
            const char* a1 = Ak + (size_t)(t + 1) * kstep;
            const char* a2 = last ? nAk : Ak + (size_t)(t + 2) * kstep; const char* b2 = last ? nB : cB + (size_t)(t + 2) * kstep;
            const char* a3 = a2 + kstep; const char* b3 = b2 + kstep;
            PG8_LDB(B0, 0, 0); if constexpr (NB == 2) PG8_LDB(B1, 0, 1); PG8_SCHED; PG8_LDA(At, 0, 0); PG8_STAGE(PG8_SA(1, 1), a1, vAc[1]);
            if (roll) PG8_ROWOFFS_H(vAc, n_pm, (ui + 1) & 1, 1);
            PG8_WAIT_LOOP; PG8_WAIT_L(0); PG8_BAR; PG8_MMA(0, 0, At, B0); if constexpr (NB == 2) PG8_MMA(0, 1, At, B1); PG8_BAR; PG8_SCHED;
            PG8_LDA(At, 0, 1); PG8_STAGE(PG8_SB(0, 0), b2, voffB); if constexpr (NB == 2) PG8_STAGE(PG8_SB(0, 1), b2 + hstep, voffB); PG8_STAGE(PG8_SA(0, 0), a2, vAc[0]);
            PG8_WAIT_LOOP; PG8_WAIT_L(0); PG8_BAR; PG8_MMA(1, 0, At, B0); if constexpr (NB == 2) PG8_MMA(1, 1, At, B1); PG8_BAR; PG8_SCHED;
            PG8_LDB(B0, 1, 0); if constexpr (NB == 2) PG8_LDB(B1, 1, 1); PG8_SCHED; PG8_LDA(At, 1, 0); PG8_STAGE(PG8_SA(0, 1), a2, vAc[1]);
            PG8_WAIT_LOOP; PG8_WAIT_L(0); PG8_BAR; PG8_MMA(0, 0, At, B0); if constexpr (NB == 2) PG8_MMA(0, 1, At, B1); PG8_BAR; PG8_SCHED;
            PG8_LDA(At, 1, 1); PG8_STAGE(PG8_SB(1, 0), b3, voffB); if constexpr (NB == 2) PG8_STAGE(PG8_SB(1, 1), b3 + hstep, voffB); PG8_STAGE(PG8_SA(1, 0), a3, vAc[0]);
            PG8_WAIT_LOOP; PG8_WAIT_L(0); PG8_BAR; PG8_MMA(1, 0, At, B0); if constexpr (NB == 2) PG8_MMA(1, 1, At, B1); PG8_BAR; PG8_SCHED;
        }
        if (wr == 0) PG8_BAR;
        E(acc, CUR_U, wr, wc, fr, fq);
        if (!has_next) break;
#pragma unroll
        for (int a = 0; a < 2; ++a)
#pragma unroll
            for (int b = 0; b < 2; ++b)
#pragma unroll
                for (int m = 0; m < 4; ++m)
#pragma unroll
                    for (int n = 0; n < 2; ++n) acc[a][b][m][n] = (f32x4){0.f, 0.f, 0.f, 0.f};
        c_pm = n_pm; c_pn = n_pn; c_pb = n_pb; c_ko = n_ko; cB = nB; Ak = nAk; ++ui;
        if (wr == 1) PG8_BAR;
    }
    PG8_WAIT_V(0);
    PG8_BAR;
#undef PG8_SA
#undef PG8_SB
#undef PG8_STAGE
#undef PG8_LDA
#undef PG8_LDB
#undef PG8_MMA
#undef PG8_WAIT_V
#undef PG8_WAIT_L
#undef PG8_WAIT_LOOP
#undef PG8_BAR
#undef PG8_SCHED
#undef PG8_ROWOFFS_H
#undef CUR_U
#undef NXT_U
}

#ifndef EPI_SC1
#define EPI_SC1 0
#endif
__device__ __forceinline__ void st16(const void* base, void* p, u32x4 v) {
    if (EPI_SC1) { const __amdgpu_buffer_rsrc_t rs = __builtin_amdgcn_make_buffer_rsrc((void*)base, 0, 0xFFFFFFFF, 0x00020000);
        __builtin_amdgcn_raw_buffer_store_b128(v, rs, (int)(unsigned)((const char*)p - (const char*)base), 0, 16); }
    else *(u32x4*)p = v; }
__device__ __forceinline__ void st16f(const void* base, void* p, f32x4 v) { st16(base, p, __builtin_bit_cast(u32x4, v)); }
__device__ __forceinline__ void st8(const void* base, void* p, u32x2 v) {
    if (EPI_SC1) { const __amdgpu_buffer_rsrc_t rs = __builtin_amdgcn_make_buffer_rsrc((void*)base, 0, 0xFFFFFFFF, 0x00020000);
        __builtin_amdgcn_raw_buffer_store_b64(v, rs, (int)(unsigned)((const char*)p - (const char*)base), 0, 16); }
    else *(u32x2*)p = v; }
struct EpiWin {
    static constexpr bool PERM = true, HOOK = false;
    bf16* P; const float* rope; const float* gbias; float oscale;
    __device__ __forceinline__ void operator()(const f32x4 (&acc)[2][2][4][2], const Unit& u, int wr, int wc, int fr, int fq) const {
        const int row0 = u.pm * BM + wr * 64 + fr, col0 = u.pn * BM + wc * 32 + 8 * fq;
#pragma unroll
        for (int ai = 0; ai < 2; ++ai)
#pragma unroll
            for (int m = 0; m < 4; ++m) { const int r = row0 + ai * HALF + m * 16; bf16* rowp = P + (size_t)r * PSTR + col0;
#pragma unroll
                for (int bj = 0; bj < 2; ++bj) { f32x4 v0 = acc[ai][bj][m][0] * oscale, v1 = acc[ai][bj][m][1] * oscale; const int c = col0 + bj * HALF;
                    if (u.pn < 3 && c < OVA && r < RL) { const int s = r & (SEQ - 1), pi0 = (c & 63) >> 1;
                        const f32x4 cs = *(const f32x4*)(rope + s * 32 + pi0), sn = *(const f32x4*)(rope + SEQ * 32 + s * 32 + pi0);
                        const f32x4 a0 = v0, a1 = v1;
                        v0[0] = a0[0] * cs[0] - a0[1] * sn[0]; v0[1] = a0[0] * sn[0] + a0[1] * cs[0]; v0[2] = a0[2] * cs[1] - a0[3] * sn[1]; v0[3] = a0[2] * sn[1] + a0[3] * cs[1];
                        v1[0] = a1[0] * cs[2] - a1[1] * sn[2]; v1[1] = a1[0] * sn[2] + a1[1] * cs[2]; v1[2] = a1[2] * cs[3] - a1[3] * sn[3]; v1[3] = a1[2] * sn[3] + a1[3] * cs[3]; }
                    if (c >= OBG && c < DIN) { constexpr float NL2E = -1.4426950408889634f;
                        const f32x4 b0 = *(const f32x4*)(gbias + (c - OBG)) * NL2E, b1 = *(const f32x4*)(gbias + (c - OBG) + 4) * NL2E; const float sc2 = oscale * NL2E;
#pragma unroll
                        for (int j = 0; j < 4; ++j) { v0[j] = __builtin_amdgcn_rcpf(1.0f + __builtin_amdgcn_exp2f(__builtin_fmaf(acc[ai][bj][m][0][j], sc2, b0[j])));
                                                      v1[j] = __builtin_amdgcn_rcpf(1.0f + __builtin_amdgcn_exp2f(__builtin_fmaf(acc[ai][bj][m][1][j], sc2, b1[j]))); } }
                    u32x4 w; w.x = cvt_pk_bf16(v0[0], v0[1]); w.y = cvt_pk_bf16(v0[2], v0[3]); w.z = cvt_pk_bf16(v1[0], v1[1]); w.w = cvt_pk_bf16(v1[2], v1[3]);
                    st16(P, (void*)(rowp + bj * HALF), w); } }
    }
};
struct EpiBf {
    static constexpr bool PERM = true, HOOK = false;
    bf16* O; int ldc;
    __device__ __forceinline__ void operator()(const f32x4 (&acc)[2][2][4][2], const Unit& u, int wr, int wc, int fr, int fq) const {
        const int row0 = u.pm * BM + wr * 64 + fr, col0 = u.pn * BM + wc * 32 + 8 * fq;
#pragma unroll
        for (int ai = 0; ai < 2; ++ai)
#pragma unroll
            for (int m = 0; m < 4; ++m) { bf16* rowp = O + (size_t)(row0 + ai * HALF + m * 16) * ldc + col0;
#pragma unroll
                for (int bj = 0; bj < 2; ++bj) { const f32x4 v0 = acc[ai][bj][m][0], v1 = acc[ai][bj][m][1];
                    u32x4 w; w.x = cvt_pk_bf16(v0[0], v0[1]); w.y = cvt_pk_bf16(v0[2], v0[3]); w.z = cvt_pk_bf16(v1[0], v1[1]); w.w = cvt_pk_bf16(v1[2], v1[3]);
                    st16(O, (void*)(rowp + bj * HALF), w); } }
    }
};
struct EpiF8 {
    static constexpr int PERM = 2; static constexpr bool HOOK = false;
    unsigned char* O; int ldc; float scale;
    __device__ __forceinline__ void operator()(const f32x4 (&acc)[2][2][4][2], const Unit& u, int wr, int wc, int fr, int fq) const {
        const int row0 = u.pm * BM + wr * 64 + fr, col0 = u.pn * BM + wc * 64 + 16 * fq;
#pragma unroll
        for (int ai = 0; ai < 2; ++ai)
#pragma unroll
            for (int m = 0; m < 4; ++m) { unsigned char* rowp = O + (size_t)(row0 + ai * HALF + m * 16) * ldc + col0;
                u32x4 w;
#pragma unroll
                for (int bj = 0; bj < 2; ++bj) { const f32x4 v0 = acc[ai][bj][m][0] * scale, v1 = acc[ai][bj][m][1] * scale;
                    w[2 * bj] = pk4_fp8(v0[0], v0[1], v0[2], v0[3]); w[2 * bj + 1] = pk4_fp8(v1[0], v1[1], v1[2], v1[3]); }
                st16(O, (void*)rowp, w); }
    }
};
template <int NBJ = 2> struct EpiWout {
    static constexpr int NST = 16;
    static constexpr bool PERM = true, HOOK = false;
    bf16* Y; const float* mod; int g; float ascale;
    __device__ __forceinline__ void operator()(const f32x4 (&acc)[2][2][4][2], const Unit& u, int wr, int wc, int fr, int fq) const {
        const int rt = u.pm * BM; const int mrow = rt < RL ? (g * GB + (rt >> 11)) : 16;
        const int row0 = rt + wr * 64 + fr, col0 = u.pn * (NBJ * HALF) + wc * 32 + 8 * fq;
        const float* g1 = mod + (size_t)mrow * 6144 + 2048 + col0;
        f32x4 gv[2][2];
#pragma unroll
        for (int bj = 0; bj < NBJ; ++bj)
#pragma unroll
            for (int n = 0; n < 2; ++n) gv[bj][n] = *(const f32x4*)(g1 + bj * HALF + n * 4) * ascale;
#pragma unroll
        for (int ai = 0; ai < 2; ++ai)
#pragma unroll
            for (int m = 0; m < 4; ++m) { bf16* rowp = Y + (size_t)(row0 + ai * HALF + m * 16) * D + col0;
#pragma unroll
                for (int bj = 0; bj < NBJ; ++bj) { const f32x4 v0 = acc[ai][bj][m][0] * gv[bj][0], v1 = acc[ai][bj][m][1] * gv[bj][1];
                    u32x4 w; w.x = cvt_pk_bf16(v0[0], v0[1]); w.y = cvt_pk_bf16(v0[2], v0[3]); w.z = cvt_pk_bf16(v1[0], v1[1]); w.w = cvt_pk_bf16(v1[2], v1[3]);
                    st16(Y, (void*)(rowp + bj * HALF), w); } }
    }
};
struct EpiMoe1 {
    static constexpr bool PERM = true, HOOK = false;
    bf16* H; int h8;
    __device__ __forceinline__ void operator()(const f32x4 (&acc)[2][2][4][2], const Unit& u, int wr, int wc, int fr, int fq) const {
        const int row0 = u.pm * BM + wr * 64 + fr, col0 = u.pn * HALF + wc * 32 + 8 * fq;
#pragma unroll
        for (int ai = 0; ai < 2; ++ai)
#pragma unroll
            for (int m = 0; m < 4; ++m) { const int r = row0 + ai * HALF + m * 16;
                float o[8];
#pragma unroll
                for (int n = 0; n < 2; ++n)
#pragma unroll
                    for (int j = 0; j < 4; ++j) { const float gv = acc[ai][0][m][n][j] * (FP8_MOE1 ? 1.0f / WIN_SCALE : 1.0f); o[n * 4 + j] = gv * __builtin_amdgcn_rcpf(1.0f + __expf(-gv)) * (acc[ai][1][m][n][j] * (FP8_MOE1 ? 1.0f / WIN_SCALE : 1.0f)); }
                if (h8) { u32x2 q8; q8.x = pk4_fp8(o[0] * H_SCALE, o[1] * H_SCALE, o[2] * H_SCALE, o[3] * H_SCALE); q8.y = pk4_fp8(o[4] * H_SCALE, o[5] * H_SCALE, o[6] * H_SCALE, o[7] * H_SCALE);
                    st8(H, (void*)((unsigned char*)H + (size_t)r * EFF + col0), q8); }
                else { u32x4 q; q.x = cvt_pk_bf16(o[0], o[1]); q.y = cvt_pk_bf16(o[2], o[3]); q.z = cvt_pk_bf16(o[4], o[5]); q.w = cvt_pk_bf16(o[6], o[7]);
                    st16(H, (void*)(H + (size_t)r * EFF + col0), q); } }
    }
};
template <int NBJ = 2> struct EpiMerge {
    static constexpr bool PERM = true, HOOK = true;
    bf16* O; const bf16* P; unsigned char* O8; float ascale;
    __device__ __forceinline__ static float gclamp(float g) { return fmaxf(g, 1e-20f); }
    __device__ __forceinline__ void hook(f32x4 (&acc)[2][2][4][2], const Unit& u, int seg  , int wr, int wc, int fr, int fq) const {
        int row0 = u.pm * BM + wr * 64 + fr; asm volatile("" : "+v"(row0));
        const unsigned off0 = ((unsigned)row0 * PSTR + OBG + (seg - 1) * D + u.pn * (NBJ * HALF) + wc * 32 + 8 * fq) * 2u;
        const char* Pb = (const char*)P;
#pragma unroll
        for (int ai = 0; ai < 2; ++ai) {
            u32x4 ga[4][NBJ], gb[4][NBJ];
#pragma unroll
            for (int m = 0; m < 4; ++m)
#pragma unroll
                for (int bj = 0; bj < NBJ; ++bj) { const unsigned off = off0 + (unsigned)((ai * HALF + m * 16) * PSTR * 2);
                    ga[m][bj] = *(const u32x4*)(Pb + off + bj * HALF * 2); gb[m][bj] = *(const u32x4*)(Pb + off + (D + bj * HALF) * 2); }
            asm volatile("" ::: "memory");
#pragma unroll
            for (int m = 0; m < 4; ++m)
#pragma unroll
                for (int bj = 0; bj < NBJ; ++bj)
#pragma unroll
                    for (int e = 0; e < 4; ++e) { const float r0 = gclamp(blo(ga[m][bj][e])) * __builtin_amdgcn_rcpf(gclamp(blo(gb[m][bj][e]))), r1 = gclamp(bhi(ga[m][bj][e])) * __builtin_amdgcn_rcpf(gclamp(bhi(gb[m][bj][e])));
                        acc[ai][bj][m][e >> 1][(e & 1) * 2] *= r0; acc[ai][bj][m][e >> 1][(e & 1) * 2 + 1] *= r1; }
            asm volatile("" ::: "memory"); }
    }
    __device__ __forceinline__ void operator()(const f32x4 (&acc)[2][2][4][2], const Unit& u, int wr, int wc, int fr, int fq) const {
        const int row0 = u.pm * BM + wr * 64 + fr, col0 = u.pn * (NBJ * HALF) + wc * 32 + 8 * fq;
#pragma unroll
        for (int ai = 0; ai < 2; ++ai)
#pragma unroll
            for (int m = 0; m < 4; ++m) { const int r = row0 + ai * HALF + m * 16; const bf16* gp = P + (size_t)r * PSTR + OBG + 2 * D + col0;
#pragma unroll
                for (int bj = 0; bj < NBJ; ++bj) { const u32x4 gc = *(const u32x4*)(gp + bj * HALF); const f32x4 v0 = acc[ai][bj][m][0] * ascale, v1 = acc[ai][bj][m][1] * ascale;
                    float o[8]; o[0] = v0[0] * gclamp(blo(gc[0])); o[1] = v0[1] * gclamp(bhi(gc[0])); o[2] = v0[2] * gclamp(blo(gc[1])); o[3] = v0[3] * gclamp(bhi(gc[1]));
                    o[4] = v1[0] * gclamp(blo(gc[2])); o[5] = v1[1] * gclamp(bhi(gc[2])); o[6] = v1[2] * gclamp(blo(gc[3])); o[7] = v1[3] * gclamp(bhi(gc[3]));
                    if (O8) { u32x2 w8; w8.x = pk4_fp8(o[0] * YM_SCALE, o[1] * YM_SCALE, o[2] * YM_SCALE, o[3] * YM_SCALE); w8.y = pk4_fp8(o[4] * YM_SCALE, o[5] * YM_SCALE, o[6] * YM_SCALE, o[7] * YM_SCALE);
                        *(u32x2*)(O8 + (size_t)r * D + col0 + bj * HALF) = w8; }
                    else { u32x4 w; w.x = cvt_pk_bf16(o[0], o[1]); w.y = cvt_pk_bf16(o[2], o[3]); w.z = cvt_pk_bf16(o[4], o[5]); w.w = cvt_pk_bf16(o[6], o[7]);
                        st16(O, (void*)(O + (size_t)r * D + col0 + bj * HALF), w); } } }
    }
};
template <int NBJ = 2> struct EpiMerge3 {
    static constexpr bool PERM = true, HOOK = false;
    bf16* O; bf16* PA; const bf16* P; unsigned char* O8; float ascale, pad_;
    __device__ __forceinline__ void operator()(const f32x4 (&acc)[2][2][4][2], const Unit& u, int wr, int wc, int fr, int fq) const {
        const int seg = u.kofs >> 9;
        const unsigned row0 = (unsigned)(u.pm * BM + wr * 64 + fr), col0 = (unsigned)(u.pn * (NBJ * HALF) + wc * 32 + 8 * fq);
        const char* srcb = (const char*)((seg == 1) ? PA : O); char* dstb = (char*)((seg == 0) ? PA : O); const char* Pb = (const char*)P;
        const unsigned goff0 = (row0 * PSTR + OBG + (unsigned)seg * D + col0) * 2u, yoff0 = (row0 * D + col0) * 2u;
#pragma unroll
        for (int ai = 0; ai < 2; ++ai)
#pragma unroll
            for (int mh = 0; mh < 2; ++mh) {
                u32x4 gg[2][2], pp[2][2];
#pragma unroll
                for (int m2 = 0; m2 < 2; ++m2)
#pragma unroll
                    for (int bj = 0; bj < NBJ; ++bj) { const unsigned rr = (unsigned)(ai * HALF + (mh * 2 + m2) * 16);
                        gg[m2][bj] = *(const u32x4*)(Pb + goff0 + rr * (PSTR * 2) + bj * HALF * 2);
                        pp[m2][bj] = *(const u32x4*)(srcb + yoff0 + rr * (D * 2) + bj * HALF * 2); }
#pragma unroll
                for (int m2 = 0; m2 < 2; ++m2)
#pragma unroll
                    for (int bj = 0; bj < NBJ; ++bj) { const int m = mh * 2 + m2; const unsigned rr = (unsigned)(ai * HALF + m * 16); const f32x4 v0 = acc[ai][bj][m][0] * ascale, v1 = acc[ai][bj][m][1] * ascale; const u32x4 g = gg[m2][bj];
                        u32x4 p = pp[m2][bj]; if (seg == 0) p = (u32x4){0u, 0u, 0u, 0u};
                        float o[8]; o[0] = blo(p[0]) + v0[0] * blo(g[0]); o[1] = bhi(p[0]) + v0[1] * bhi(g[0]); o[2] = blo(p[1]) + v0[2] * blo(g[1]); o[3] = bhi(p[1]) + v0[3] * bhi(g[1]);
                        o[4] = blo(p[2]) + v1[0] * blo(g[2]); o[5] = bhi(p[2]) + v1[1] * bhi(g[2]); o[6] = blo(p[3]) + v1[2] * blo(g[3]); o[7] = bhi(p[3]) + v1[3] * bhi(g[3]);
                        if (seg == 2 && O8) { u32x2 w8; w8.x = pk4_fp8(o[0] * YM_SCALE, o[1] * YM_SCALE, o[2] * YM_SCALE, o[3] * YM_SCALE); w8.y = pk4_fp8(o[4] * YM_SCALE, o[5] * YM_SCALE, o[6] * YM_SCALE, o[7] * YM_SCALE);
                            *(u32x2*)(O8 + (yoff0 >> 1) + rr * D + bj * HALF) = w8; }
                        else { u32x4 w; w.x = cvt_pk_bf16(o[0], o[1]); w.y = cvt_pk_bf16(o[2], o[3]); w.z = cvt_pk_bf16(o[4], o[5]); w.w = cvt_pk_bf16(o[6], o[7]);
                            *(u32x4*)(dstb + yoff0 + rr * (D * 2) + bj * HALF * 2) = w; } }
                asm volatile("" ::: "memory"); }
    }
};
}

struct Args { const float* in[27]; float* out; unsigned char* ws; int ph_lo, ph_hi; };
struct Frame {
    LAS unsigned char* lds;
    int tid, lane, wave, G, gtid, nthr, gwave, nwave;
    unsigned char* ws;
    const __attribute__((address_space(4))) Args* a;
};
#define gMOD ((float*)(F.ws + (WS_MOD)))
#define gROPE ((float*)(F.ws + (WS_ROPE)))
#define gX ((float*)(F.ws + (WS_X)))
#define gXb ((bf16*)(F.ws + (WS_X)))
#define gHDIR ((float*)(F.ws + (WS_HDIR)))
#define gA ((bf16*)(F.ws + (WS_A)))
#define gP ((bf16*)(F.ws + (WS_P)))
#define gYATT ((bf16*)(F.ws + (WS_YATT)))
#define gYMLS (gYATT + 512)
#define gYCONV (gYATT + 1024)
#define gYP ((bf16*)(F.ws + (WS_YP)))
#define gYMERGE ((bf16*)(F.ws + (WS_YMERGE)))
#define gH ((bf16*)(F.ws + (WS_H)))
#define gYS ((bf16*)(F.ws + (WS_YS)))
#define gEIDX ((int*)(F.ws + (WS_ROUTE + RT_EIDX)))
#define gEW ((float*)(F.ws + (WS_ROUTE + RT_EW)))
#define gSPOS ((int*)(F.ws + (WS_ROUTE + RT_SPOS)))
#define gROWTOK ((int*)(F.ws + (WS_ROUTE + RT_ROWTOK)))
#define gROWW ((float*)(F.ws + (WS_ROUTE + RT_ROWW)))
#define gTILEE ((int*)(F.ws + (WS_ROUTE + RT_TILEE)))
#define gNT ((int*)(F.ws + (WS_ROUTE + RT_NT)))
#define gRT2 ((int*)(F.ws + WS_HDIR + 20 * MiB))
#define gCTL ((unsigned*)(F.ws + (WS_CTL)))
#define i_x (F.a->in[0])
#define i_c (F.a->in[1])
#define i_ctx (F.a->in[2])
#define i_c_ctx (F.a->in[3])
#define i_ada_w (F.a->in[4])
#define i_ada_b (F.a->in[5])
#define i_norm1_g (F.a->in[6])
#define i_norm2_g (F.a->in[7])
#define i_w_in (F.a->in[8])
#define i_attn_sink (F.a->in[9])
#define i_gate_b (F.a->in[10])
#define i_mnorm_g (F.a->in[11])
#define i_conv_w (F.a->in[12])
#define i_w_br0 (F.a->in[13])
#define i_w_br1 (F.a->in[14])
#define i_w_br2 (F.a->in[15])
#define i_bgate_b (F.a->in[16])
#define i_w_out (F.a->in[17])
#define i_router_w (F.a->in[18])
#define i_router_b (F.a->in[19])
#define i_ew_gate (F.a->in[20])
#define i_ew_up (F.a->in[21])
#define i_ew_down (F.a->in[22])
#define i_sw_gate (F.a->in[23])
#define i_sw_up (F.a->in[24])
#define i_sw_down (F.a->in[25])
#define i_final_g (F.a->in[26])
#define i_out (F.a->out)
#define gA8 ((unsigned char*)(F.ws + WS_A8))
#define gA8n ((unsigned char*)(F.ws + WS_A + 9 * MiB))
static_assert(FP8_WIN_MASK == 3 && FP8_MOE1 == 1 && FP8_MRG_MASK != 0, "gA8n overlays the upper half of the (otherwise unused) bf16 A buffer");
#define gWRT ((bf16*)(F.ws + WS_ROPE + 512 * 1024))
__device__ __forceinline__ int row_batch(int g, int r) { return g * GB + (r < RL ? (r >> 11) : ((r - RL) >> 8)); }
__device__ __forceinline__ int row_modrow(int g, int r) { return r < RL ? row_batch(g, r) : 16; }
__device__ __forceinline__ const float* row_input(const Frame& F, int g, int r) {
    if (r < RL) return i_x + ((size_t)(g * GB + (r >> 11)) * SEQ + (r & 2047)) * D;
    const int rc = r - RL; return i_ctx + ((size_t)(g * GB + (rc >> 8)) * CTXL + (rc & 255)) * D;
}

__device__ __forceinline__ void ph_prologue(Frame& F) {
    for (int i = F.gtid; i < SEQ * 32; i += F.nthr) {
        const int s = i >> 5, pi = i & 31, j = pi & 15;
        const float pos = (pi < 16) ? (float)(s >> 6) : (float)(s & 63);
        const float invf = exp2f(-(float)j * (13.287712379549449f / 16.0f));
        const float ang = pos * invf;
        gROPE[i] = __cosf(ang); gROPE[SEQ * 32 + i] = __sinf(ang);
    }
    for (int i = F.gtid; i < DEPTH * NE * D; i += F.nthr) { const int l = i / (NE * D), e = (i / D) % NE, k = i % D;
        const float w = i_router_w[((size_t)l * D + k) * NE + e]; const unsigned hi = f2bf(w);
        gWRT[(size_t)l * 2 * NE * D + e * D + k] = (bf16)hi; gWRT[(size_t)l * 2 * NE * D + NE * D + e * D + k] = (bf16)f2bf(w - __uint_as_float(hi << 16)); }
    LAS float* sl = (LAS float*)F.lds;
    LAS float* red = (LAS float*)(F.lds + 17 * 1024 * 4);
    for (int i = F.tid; i < 17 * 1024; i += NTHR) { const int row = i >> 10, k = i & 1023; const float v = row < 16 ? i_c[row * 1024 + k] : i_c_ctx[k]; sl[i] = v / (1.0f + __expf(-v)); }
    __syncthreads();
    for (int item = blockIdx.x; item < DEPTH * 192; item += F.G) {
        const int l = item / 192, n0 = (item % 192) * 32, col = F.tid & 31, ks = F.tid >> 5;
        float acc[17];
#pragma unroll
        for (int r = 0; r < 17; ++r) acc[r] = 0.f;
        const float* wp = i_ada_w + ((size_t)l * 1024 + ks * 64) * 6144 + n0 + col;
        float wq[64];
#pragma unroll
        for (int kk = 0; kk < 64; ++kk) wq[kk] = wp[(size_t)kk * 6144];
#pragma unroll
        for (int kk = 0; kk < 64; ++kk) { const float w = wq[kk];
#pragma unroll
            for (int r = 0; r < 17; ++r) acc[r] += sl[r * 1024 + ks * 64 + kk] * w; }
#pragma unroll
        for (int r = 0; r < 17; ++r) red[(ks * 17 + r) * 32 + col] = acc[r];
        __syncthreads();
        for (int o = F.tid; o < 17 * 32; o += NTHR) { const int r = o >> 5, cc = o & 31; float s = 0.f;
#pragma unroll
            for (int k2 = 0; k2 < 16; ++k2) s += red[(k2 * 17 + r) * 32 + cc];
            gMOD[((size_t)l * 17 + r) * 6144 + n0 + cc] = s + i_ada_b[l * 6144 + n0 + cc]; }
        __syncthreads();
    }
}

__device__ __forceinline__ void norm_mod_store_bf16(const f32x4 (&v)[4], const float* gain, const float* sh, const float* sc, bf16* orow, int lane) {
    float ss = 0.f;
#pragma unroll
    for (int j = 0; j < 4; ++j) ss += (v[j].x * v[j].x + v[j].y * v[j].y) + (v[j].z * v[j].z + v[j].w * v[j].w);
    const float rs = rsqrtf(wave_sum(ss) * (1.0f / D) + EPS);
#pragma unroll
    for (int j = 0; j < 4; ++j) { const int c0 = 4 * lane + 256 * j;
        const f32x4 gq = *(const f32x4*)(gain + c0), sq = *(const f32x4*)(sc + c0), hq = *(const f32x4*)(sh + c0);
        const f32x4 o = v[j] * rs * gq * (sq + 1.0f) + hq;
        u32x2 w; w.x = pk2(o.x, o.y); w.y = pk2(o.z, o.w); *(u32x2*)(orow + c0) = w; }
}
__device__ __forceinline__ void norm_mod_store_fp8(const f32x4 (&v)[4], const float* gain, const float* sh, const float* sc, unsigned char* orow, int lane) {
    float ss = 0.f;
#pragma unroll
    for (int j = 0; j < 4; ++j) ss += (v[j].x * v[j].x + v[j].y * v[j].y) + (v[j].z * v[j].z + v[j].w * v[j].w);
    const float rs = rsqrtf(wave_sum(ss) * (1.0f / D) + EPS);
#pragma unroll
    for (int j = 0; j < 4; ++j) { const int c0 = 4 * lane + 256 * j;
        const f32x4 gq = *(const f32x4*)(gain + c0), sq = *(const f32x4*)(sc + c0), hq = *(const f32x4*)(sh + c0);
        const f32x4 o = v[j] * rs * gq * (sq + 1.0f) + hq;
        *(unsigned*)(orow + c0) = pk4_fp8(o.x, o.y, o.z, o.w); }
}
__device__ __forceinline__ void ph_norm1_input(Frame& F, int g, int worker, int nworker) {
    for (int r = worker; r < R; r += nworker) {
        const float* xr = row_input(F, g, r); f32x4 v[4];
#pragma unroll
        for (int j = 0; j < 4; ++j) v[j] = *(const f32x4*)(xr + 4 * F.lane + 256 * j);
        const float* mod = gMOD + (size_t)(0 * 17 + row_modrow(g, r)) * 6144;
        norm_mod_store_fp8(v, i_norm1_g, mod, mod + 1024, gA8n + (size_t)r * D, F.lane);
    }
}
__device__ __forceinline__ int moe_tiles_to_lds(Frame& F, int g, int l);
__device__ __forceinline__ void ph_combine(Frame& F, int g, int l) {
    typedef float f32x2_ __attribute__((ext_vector_type(2)));
    const int nrows = (l == 0) ? R : RL; const int spsh = (moe_tiles_to_lds(F, g, l) - nrows / 256) * 256;
    const LAS int* toff = (const LAS int*)(F.lds + pg8::TILEE_OFF) + 512;
    const unsigned char* yp8 = (const unsigned char*)gYP;
    const int c0 = 16 * F.lane;
    for (int rb = F.gwave; rb < nrows; rb += 2 * F.nwave) {
        int rr[2]; rr[0] = rb; rr[1] = (rb + F.nwave < nrows) ? rb + F.nwave : rb;
        u32x4 xb[2][2]; u32x4 pw[2][9]; f32x4 g2v[2][4]; f32x4 wv[2][2];
#pragma unroll
        for (int q = 0; q < 2; ++q) { const int r = rr[q];
            const float* mod = gMOD + (size_t)(l * 17 + row_modrow(g, r)) * 6144;
            int sp[8];
            { const u32x4 e0 = *(const u32x4*)(gEIDX + r * 8), e1 = *(const u32x4*)(gEIDX + r * 8 + 4), q0 = *(const u32x4*)(gSPOS + r * 8), q1 = *(const u32x4*)(gSPOS + r * 8 + 4);
              wv[q][0] = *(const f32x4*)(gEW + r * 8); wv[q][1] = *(const f32x4*)(gEW + r * 8 + 4);
#pragma unroll
              for (int s = 0; s < 4; ++s) { sp[s] = toff[e0[s]] * 256 + (int)q0[s]; sp[4 + s] = toff[e1[s]] * 256 + (int)q1[s]; } }
#pragma unroll
            for (int j = 0; j < 4; ++j) g2v[q][j] = *(const f32x4*)(mod + 5120 + c0 + 4 * j);
            xb[q][0] = *(const u32x4*)(gXb + (size_t)r * D + c0); xb[q][1] = *(const u32x4*)(gXb + (size_t)r * D + c0 + 8);
            pw[q][8] = *(const u32x4*)(yp8 + (size_t)(spsh + r) * D + c0);
#pragma unroll
            for (int s = 0; s < 8; ++s) pw[q][s] = *(const u32x4*)(yp8 + (size_t)sp[s] * D + c0); }
#pragma unroll
        for (int q = 0; q < 2; ++q) { const int r = rr[q];
            f32x4 v[4];
#pragma unroll
            for (int j = 0; j < 4; ++j) { f32x4 m = (f32x4){0.f, 0.f, 0.f, 0.f};
#pragma unroll
                for (int s = 0; s < 9; ++s) { const unsigned w = pw[q][s][j]; const f32x2_ lo = __builtin_amdgcn_cvt_pk_f32_fp8((int)w, false), hi = __builtin_amdgcn_cvt_pk_f32_fp8((int)w, true);
                    const float ws = (s < 8) ? wv[q][s >> 2][s & 3] : 1.0f; m += (f32x4){lo.x, lo.y, hi.x, hi.y} * ws; }
                const unsigned xa = xb[q][j >> 1][(j & 1) * 2], xc = xb[q][j >> 1][(j & 1) * 2 + 1];
                v[j] = (f32x4){blo(xa), bhi(xa), blo(xc), bhi(xc)} + g2v[q][j] * (m * (1.0f / YP_SCALE)); }
            float ss = 0.f;
#pragma unroll
            for (int j = 0; j < 4; ++j) ss += (v[j].x * v[j].x + v[j].y * v[j].y) + (v[j].z * v[j].z + v[j].w * v[j].w);
            const float rs = rsqrtf(wave_sum(ss) * (1.0f / D) + EPS);
            if (l == 0) {
#pragma unroll
                for (int j = 0; j < 2; ++j) { u32x4 xo; xo.x = pk2(v[2 * j].x, v[2 * j].y); xo.y = pk2(v[2 * j].z, v[2 * j].w); xo.z = pk2(v[2 * j + 1].x, v[2 * j + 1].y); xo.w = pk2(v[2 * j + 1].z, v[2 * j + 1].w); *(u32x4*)(gXb + (size_t)r * D + c0 + 8 * j) = xo; }
                const float* mod1 = gMOD + (size_t)(1 * 17 + row_modrow(g, r)) * 6144;
                f32x4 o[4];
#pragma unroll
                for (int j = 0; j < 4; ++j) o[j] = v[j] * rs * *(const f32x4*)(i_norm1_g + D + c0 + 4 * j) * (*(const f32x4*)(mod1 + 1024 + c0 + 4 * j) + 1.0f) + *(const f32x4*)(mod1 + c0 + 4 * j);
                if (FP8_WIN_L(1)) { u32x4 w;
#pragma unroll
                    for (int j = 0; j < 4; ++j) w[j] = pk4_fp8(o[j].x, o[j].y, o[j].z, o[j].w);
                    *(u32x4*)(gA8 + (size_t)r * D + c0) = w; }
                else { u32x4 w0, w1; w0.x = pk2(o[0].x, o[0].y); w0.y = pk2(o[0].z, o[0].w); w0.z = pk2(o[1].x, o[1].y); w0.w = pk2(o[1].z, o[1].w);
                    w1.x = pk2(o[2].x, o[2].y); w1.y = pk2(o[2].z, o[2].w); w1.z = pk2(o[3].x, o[3].y); w1.w = pk2(o[3].z, o[3].w);
                    *(u32x4*)(gA + (size_t)r * D + c0) = w0; *(u32x4*)(gA + (size_t)r * D + c0 + 8) = w1; }
            } else {
                float* orow = i_out + ((size_t)(g * GB + (r >> 11)) * SEQ + (r & 2047)) * D;
#pragma unroll
                for (int j = 0; j < 4; ++j) *(f32x4*)(orow + c0 + 4 * j) = v[j] * rs * *(const f32x4*)(i_final_g + c0 + 4 * j);
            }
        }
    }
}

__device__ __forceinline__ void ngemm_acc(float (&acc)[4][4], const bf16* a0, const bf16* a1, const bf16* a2, const bf16* a3, const float* B, int ldb, int c0, int K) {
    for (int k = 0; k < K; k += 8) {
        const u32x4 q0 = *(const u32x4*)(a0 + k), q1 = *(const u32x4*)(a1 + k), q2 = *(const u32x4*)(a2 + k), q3 = *(const u32x4*)(a3 + k);
#pragma unroll
        for (int kk = 0; kk < 8; ++kk) {
            const f32x4 b = *(const f32x4*)(B + (size_t)(k + kk) * ldb + c0);
            const unsigned w0 = q0[kk >> 1], w1 = q1[kk >> 1], w2 = q2[kk >> 1], w3 = q3[kk >> 1];
            const float x0 = (kk & 1) ? bhi(w0) : blo(w0), x1 = (kk & 1) ? bhi(w1) : blo(w1), x2 = (kk & 1) ? bhi(w2) : blo(w2), x3 = (kk & 1) ? bhi(w3) : blo(w3);
            acc[0][0] += x0 * b.x; acc[0][1] += x0 * b.y; acc[0][2] += x0 * b.z; acc[0][3] += x0 * b.w;
            acc[1][0] += x1 * b.x; acc[1][1] += x1 * b.y; acc[1][2] += x1 * b.z; acc[1][3] += x1 * b.w;
            acc[2][0] += x2 * b.x; acc[2][1] += x2 * b.y; acc[2][2] += x2 * b.z; acc[2][3] += x2 * b.w;
            acc[3][0] += x3 * b.x; acc[3][1] += x3 * b.y; acc[3][2] += x3 * b.z; acc[3][3] += x3 * b.w;
        }
    }
}
#define ZERO44(a) do { _Pragma("unroll") for (int i_ = 0; i_ < 4; ++i_) _Pragma("unroll") for (int j_ = 0; j_ < 4; ++j_) a[i_][j_] = 0.f; } while (0)

__device__ __forceinline__ void ph_win_naive(Frame& F, int l) {
    const int nq = DIN / 4; const long total = (long)(R / 4) * nq;
    const float* B = i_w_in + (size_t)l * D * DIN;
    for (long it = F.gtid; it < total; it += F.nthr) {
        const int rq = (int)(it / nq), cq = (int)(it % nq), r0 = rq * 4, c0 = cq * 4;
        float acc[4][4]; ZERO44(acc);
        const bf16* a = gA + (size_t)r0 * D;
        ngemm_acc(acc, a, a + D, a + 2 * D, a + 3 * D, B, DIN, c0, D);
        if (c0 >= OBG) { const f32x4 bb = *(const f32x4*)(i_bgate_b + (size_t)l * 3 * D + (c0 - OBG));
#pragma unroll
            for (int i = 0; i < 4; ++i) { acc[i][0] = sigmoidf_(acc[i][0] + bb.x); acc[i][1] = sigmoidf_(acc[i][1] + bb.y); acc[i][2] = sigmoidf_(acc[i][2] + bb.z); acc[i][3] = sigmoidf_(acc[i][3] + bb.w); } }
#pragma unroll
        for (int i = 0; i < 4; ++i) { u32x2 w; w.x = pk2(acc[i][0], acc[i][1]); w.y = pk2(acc[i][2], acc[i][3]); *(u32x2*)(gP + (size_t)(r0 + i) * PSTR + c0) = w; }
    }
}
__device__ __forceinline__ void ph_rope(Frame& F) {
    const long total = (long)RL * 320;
    for (long it = F.gtid; it < total; it += F.nthr) {
        const int r = (int)(it / 320), pp = (int)(it % 320);
        const int s = r & 2047;
        const int col = (pp < 256) ? (OQA + pp * 2) : (OKA + (pp - 256) * 2);
        const int pi = pp & 31;
        const float cs = gROPE[s * 32 + pi], sn = gROPE[SEQ * 32 + s * 32 + pi];
        unsigned* p = (unsigned*)(gP + (size_t)r * PSTR + col);
        const unsigned w = *p; const float x0 = blo(w), x1 = bhi(w);
        *p = pk2(x0 * cs - x1 * sn, x0 * sn + x1 * cs);
    }
}
__device__ __forceinline__ void ph_attn_naive(Frame& F, int l) {
    const int nqr = (l == 0) ? R : RL; const long total = (long)nqr * 8;
    for (long it = F.gtid; it < total; it += F.nthr) {
        const int h = (int)(it / nqr), r = (int)(it % nqr), kvh = h >> 2;
        float q[64], o[64];
        { const bf16* qp = gP + (size_t)r * PSTR + OQA + h * 64;
#pragma unroll
          for (int c = 0; c < 8; ++c) { const u32x4 w = *(const u32x4*)(qp + c * 8);
#pragma unroll
              for (int e = 0; e < 4; ++e) { q[c * 8 + 2 * e] = blo(w[e]) * 0.125f; q[c * 8 + 2 * e + 1] = bhi(w[e]) * 0.125f; } } }
#pragma unroll
        for (int d = 0; d < 64; ++d) o[d] = 0.f;
        float m = i_attn_sink[l * 8 + h], lsum = 1.0f;
        const int bl = (r < RL) ? (r >> 11) : ((r - RL) >> 8);
        int lo = 0, hi = -1;
        if (r < RL) { const int s = r & 2047; lo = s - 128 < 0 ? 0 : s - 128; hi = s + 128 > 2047 ? 2047 : s + 128; }
        const int nk = 256 + (hi - lo + 1);
        for (int kk = 0; kk < nk; ++kk) {
            const int krow = (kk < 256) ? (RL + bl * 256 + kk) : (bl * 2048 + lo + (kk - 256));
            const bf16* kp = gP + (size_t)krow * PSTR + OKA + kvh * 64; const bf16* vp = gP + (size_t)krow * PSTR + OVA + kvh * 64;
            float sc = 0.f;
#pragma unroll
            for (int c = 0; c < 8; ++c) { const u32x4 w = *(const u32x4*)(kp + c * 8);
#pragma unroll
                for (int e = 0; e < 4; ++e) sc += q[c * 8 + 2 * e] * blo(w[e]) + q[c * 8 + 2 * e + 1] * bhi(w[e]); }
            if (sc > m) { const float corr = __expf(m - sc); lsum *= corr;
#pragma unroll
                for (int d = 0; d < 64; ++d) o[d] *= corr;
                m = sc; }
            const float p = __expf(sc - m); lsum += p;
#pragma unroll
            for (int c = 0; c < 8; ++c) { const u32x4 w = *(const u32x4*)(vp + c * 8);
#pragma unroll
                for (int e = 0; e < 4; ++e) { o[c * 8 + 2 * e] += p * blo(w[e]); o[c * 8 + 2 * e + 1] += p * bhi(w[e]); } }
        }
        const float inv = 1.0f / lsum;
        bf16* op = gYATT + (size_t)r * YCS + h * 64;
#pragma unroll
        for (int c = 0; c < 8; ++c) { u32x4 w;
#pragma unroll
            for (int e = 0; e < 4; ++e) w[e] = pk2(o[c * 8 + 2 * e] * inv, o[c * 8 + 2 * e + 1] * inv);
            *(u32x4*)(op + c * 8) = w; }
    }
}
__device__ __forceinline__ void ph_mlstm_naive(Frame& F, int l) {
    for (int item = blockIdx.x; item < GB * 4 * 2; item += F.G) {
        const int bl = item >> 3, h = (item >> 1) & 3, dir = item & 1;
        const int e = F.tid >> 2, dq = F.tid & 3;
        float C[16], n[16];
#pragma unroll
        for (int d = 0; d < 16; ++d) { C[d] = 0.f; n[d] = 0.f; }
        const float bi = i_gate_b[l * 16 + (dir * 2 + 0) * 4 + h], bfg = i_gate_b[l * 16 + (dir * 2 + 1) * 4 + h];
        for (int step = 0; step < CTXL + SEQ; ++step) {
            int r;
            if (step < CTXL) { const int j = dir ? (CTXL - 1 - step) : step; r = RL + bl * CTXL + j; }
            else { const int s0 = step - CTXL; const int s = dir ? (SEQ - 1 - s0) : s0; r = bl * SEQ + s; }
            const bf16* row = gP + (size_t)r * PSTR;
            const float ig = bf2f(row[OGM + (dir * 2) * 4 + h]) + bi, fg = bf2f(row[OGM + (dir * 2 + 1) * 4 + h]) + bfg;
            const float fgate = sigmoidf_(fg), igate = __expf(ig);
            const float v = bf2f(row[OVM + h * 128 + e]);
            const u32x4 k0 = *(const u32x4*)(row + OKM + h * 64 + dq * 16), k1 = *(const u32x4*)(row + OKM + h * 64 + dq * 16 + 8);
            const u32x4 q0 = *(const u32x4*)(row + OQM + h * 64 + dq * 16), q1 = *(const u32x4*)(row + OQM + h * 64 + dq * 16 + 8);
            float hq = 0.f, nq = 0.f; const float iv = igate * v;
#pragma unroll
            for (int d = 0; d < 16; ++d) {
                const unsigned kw = (d < 8) ? k0[d >> 1] : k1[(d - 8) >> 1], qw = (d < 8) ? q0[d >> 1] : q1[(d - 8) >> 1];
                const float kd = ((d & 1) ? bhi(kw) : blo(kw)) * 0.125f, qd = (d & 1) ? bhi(qw) : blo(qw);
                C[d] = fgate * C[d] + iv * kd; n[d] = fgate * n[d] + igate * kd;
                hq += C[d] * qd; nq += n[d] * qd;
            }
            hq += __shfl_xor(hq, 1); hq += __shfl_xor(hq, 2); nq += __shfl_xor(nq, 1); nq += __shfl_xor(nq, 2);
            const float hv = hq / fmaxf(fabsf(nq), 1.0f);
            if (dq == 0 && (l == 0 || step >= CTXL)) gHDIR[((size_t)dir * R + r) * 512 + h * 128 + e] = hv;
        }
    }
}
__device__ __forceinline__ void ph_conv(Frame& F, int l) {
    const int nrows = (l == 0) ? R : RL; const long total = (long)nrows * 64;
    const float* cw = i_conv_w + (size_t)l * 3 * 512;
    long it_lo, it_hi; int it_step;
    if (F.G == 256) { int b = (int)blockIdx.x; asm volatile("" : "+s"(b)); int c0_, c1_, tot_;
        if (l == 0) { c0_ = b < 32 ? b : (b < 192 ? 32 + (b - 32) * 19 : 32 + 160 * 19 + (b - 192) * 12); c1_ = c0_ + (b < 32 ? 1 : (b < 192 ? 19 : 12)); tot_ = 32 + 160 * 19 + 64 * 12; }
        else { c0_ = b < 192 ? b * 17 : 192 * 17 + (b - 192) * 10; c1_ = c0_ + (b < 192 ? 17 : 10); tot_ = 192 * 17 + 64 * 10; }
        it_lo = total * c0_ / tot_ + F.tid; it_hi = total * c1_ / tot_; it_step = NTHR; }
    else { it_lo = F.gtid; it_hi = total; it_step = F.nthr; }
    for (long it = it_lo; it < it_hi; it += it_step) {
        const int r = (int)(it >> 6), c0 = (int)(it & 63) * 8;
        int pos, len; if (r < RL) { pos = r & 2047; len = SEQ; } else { pos = (r - RL) & 255; len = CTXL; }
        float acc[8];
#pragma unroll
        for (int e = 0; e < 8; ++e) acc[e] = 0.f;
#pragma unroll
        for (int t = 0; t < 3; ++t) { const int pp = pos + t - 1; if (pp < 0 || pp >= len) continue;
            const bf16* row = gP + (size_t)(r + t - 1) * PSTR;
            const u32x4 cq = *(const u32x4*)(row + OCC + c0), xq = *(const u32x4*)(row + OXC + c0);
#pragma unroll
            for (int e = 0; e < 4; ++e) { acc[2 * e] += cw[t * 512 + c0 + 2 * e] * blo(cq[e]) * blo(xq[e]); acc[2 * e + 1] += cw[t * 512 + c0 + 2 * e + 1] * bhi(cq[e]) * bhi(xq[e]); } }
        const u32x4 bq = *(const u32x4*)(gP + (size_t)r * PSTR + OBC + c0);
#pragma unroll
        for (int e = 0; e < 4; ++e) { acc[2 * e] *= blo(bq[e]); acc[2 * e + 1] *= bhi(bq[e]); }
        if (FP8_MRG_L(l)) { u32x2 w8; w8.x = pk4_fp8(acc[0], acc[1], acc[2], acc[3]); w8.y = pk4_fp8(acc[4], acc[5], acc[6], acc[7]); *(u32x2*)((unsigned char*)gYATT + (size_t)r * YCS + 1024 + c0) = w8; }
        else { u32x4 w;
#pragma unroll
            for (int e = 0; e < 4; ++e) w[e] = pk2(acc[2 * e], acc[2 * e + 1]);
            *(u32x4*)(gYCONV + (size_t)r * YCS + c0) = w; }
    }
}
__device__ __forceinline__ void ph_mlstm_final(Frame& F, int l) {
    const int nrows = (l == 0) ? R : RL; const long total = (long)nrows * 4;
    for (long it = F.gwave; it < total; it += F.nwave) {
        const int r = (int)(it >> 2), h = (int)(it & 3), c = h * 128 + 2 * F.lane;
        const float* hf = gHDIR + (size_t)r * 512 + c; const float* hb = gHDIR + ((size_t)R + r) * 512 + c;
        const float h0 = hf[0] + hb[0], h1 = hf[1] + hb[1];
        const float rs = rsqrtf(wave_sum(h0 * h0 + h1 * h1) * (1.0f / 128.0f) + EPS);
        const unsigned ow = *(const unsigned*)(gP + (size_t)r * PSTR + OOM + c);
        const float g0 = i_mnorm_g[l * 512 + c], g1 = i_mnorm_g[l * 512 + c + 1];
        *(unsigned*)(gYMLS + (size_t)r * YCS + c) = pk2(sigmoidf_(blo(ow)) * h0 * rs * g0, sigmoidf_(bhi(ow)) * h1 * rs * g1);
    }
}
__device__ __forceinline__ void ph_merge_naive(Frame& F, int l) {
    const int nrows = (l == 0) ? R : RL; const int nq = D / 4; const long total = (long)(nrows / 4) * nq;
    for (long it = F.gtid; it < total; it += F.nthr) {
        const int rq = (int)(it / nq), cq = (int)(it % nq), r0 = rq * 4, c0 = cq * 4;
        float res[4][4]; ZERO44(res);
#pragma unroll
        for (int b = 0; b < 3; ++b) {
            const bf16* ya = gYATT + (size_t)r0 * YCS + b * 512;
            const float* wb = (b == 0 ? i_w_br0 : b == 1 ? i_w_br1 : i_w_br2) + (size_t)l * 512 * D;
            float acc[4][4]; ZERO44(acc);
            ngemm_acc(acc, ya, ya + YCS, ya + 2 * YCS, ya + 3 * YCS, wb, D, c0, 512);
#pragma unroll
            for (int i = 0; i < 4; ++i) { const u32x2 gw = *(const u32x2*)(gP + (size_t)(r0 + i) * PSTR + OBG + b * D + c0);
                res[i][0] += blo(gw.x) * acc[i][0]; res[i][1] += bhi(gw.x) * acc[i][1];
                res[i][2] += blo(gw.y) * acc[i][2]; res[i][3] += bhi(gw.y) * acc[i][3]; }
        }
#pragma unroll
        for (int i = 0; i < 4; ++i) { u32x2 w; w.x = pk2(res[i][0], res[i][1]); w.y = pk2(res[i][2], res[i][3]); *(u32x2*)(gYMERGE + (size_t)(r0 + i) * D + c0) = w; }
    }
}
__device__ __forceinline__ void ph_wout_naive(Frame& F, int g, int l) {
    const int nrows = (l == 0) ? R : RL; const int nq = D / 4; const long total = (long)(nrows / 4) * nq;
    for (long it = F.gtid; it < total; it += F.nthr) {
        const int rq = (int)(it / nq), cq = (int)(it % nq), r0 = rq * 4, c0 = cq * 4;
        float acc[4][4]; ZERO44(acc);
        const bf16* a = gYMERGE + (size_t)r0 * D;
        ngemm_acc(acc, a, a + D, a + 2 * D, a + 3 * D, i_w_out + (size_t)l * D * D, D, c0, D);
#pragma unroll
        for (int i = 0; i < 4; ++i) { const int r = r0 + i;
            const float* src = (l == 0) ? row_input(F, g, r) : (gX + (size_t)r * D);
            const f32x4 g1 = *(const f32x4*)(gMOD + (size_t)(l * 17 + row_modrow(g, r)) * 6144 + 2048 + c0);
            const f32x4 xv = *(const f32x4*)(src + c0);
            *(f32x4*)(gX + (size_t)r * D + c0) = xv + g1 * (f32x4){acc[i][0], acc[i][1], acc[i][2], acc[i][3]}; }
    }
}
constexpr int RB = 2, WROWS = RB * NWAVES;
#define gWGBASE ((unsigned*)(F.ws + WS_ROUTE + 2 * MiB + 640 * 1024))
__device__ __forceinline__ void ph_norm2_route(Frame& F, int g, int l) {
    const int nrows = (l == 0) ? R : RL, nbatch = nrows / WROWS;
    constexpr int HP = 1028, HOFF = 16 * HP * 4;
    LAS float* hrow = (LAS float*)F.lds;
    LAS float* part = (LAS float*)(F.lds + HOFF);
    LAS unsigned* wcnt = (LAS unsigned*)(F.lds + HOFF + 34816);
    LAS unsigned* ent = (LAS unsigned*)(F.lds + HOFF + 34816 + 1024 + 8192);
    LAS unsigned* wbase = ent + 64 * 8;
    unsigned* fill = gCTL + CW_CNT + (g * DEPTH + l) * 128 + 64;
    const bf16* wrt = gWRT + (size_t)l * 2 * NE * D;
    const float rbias = i_router_b[l * NE + F.lane];
    if (F.tid < 64) wcnt[F.tid] = 0u;
    __syncthreads();
    f32x4 xv[RB][4]; u32x2 xr[RB][4];
    u32x2 dl[RB][4];
#define ROUTE_LOADX(dst, wb_) do { _Pragma("unroll") for (int i_ = 0; i_ < RB; ++i_) { const int r_ = (wb_) * WROWS + F.wave * RB + i_; \
        _Pragma("unroll") for (int j_ = 0; j_ < 4; ++j_) { if (l == 0) dst[i_][j_] = *(const f32x4*)(row_input(F, g, r_) + 4 * F.lane + 256 * j_); else xr[i_][j_] = *(const u32x2*)(gXb + (size_t)r_ * D + 4 * F.lane + 256 * j_); \
            dl[i_][j_] = *(const u32x2*)(gH + (size_t)r_ * D + 4 * F.lane + 256 * j_); } } } while (0)
    const int wb_lo = (int)(((long)blockIdx.x * nbatch) / F.G), wb_hi = (int)(((long)(blockIdx.x + 1) * nbatch) / F.G);
    LAS float* gl = (LAS float*)(F.lds + HOFF + 34816 + 1024);
    int cur_mrow = -1;
    const int ar = F.lane & 15, kq = (F.lane >> 4) * 8;
    bf16x8 wfh[2][4], wfl[2][4];
#define ROUTE_LOADW(slot, ks_) do { _Pragma("unroll") for (int et_ = 0; et_ < 4; ++et_) { const bf16* wp_ = wrt + (size_t)(et_ * 16 + ar) * D + F.wave * 128 + (ks_) * 32 + kq; \
            wfh[slot][et_] = *(const bf16x8*)wp_; wfl[slot][et_] = *(const bf16x8*)(wp_ + (size_t)NE * D); } } while (0)
    if (wb_lo < wb_hi) { ROUTE_LOADX(xv, wb_lo); ROUTE_LOADW(0, 0); ROUTE_LOADW(1, 1); }
    for (int wb = wb_lo; wb < wb_hi; ++wb) {
        const int r0 = wb * WROWS + F.wave * RB;
        const int mrow = row_modrow(g, wb * WROWS);
        if (mrow != cur_mrow) { cur_mrow = mrow; const float* mod = gMOD + (size_t)(l * 17 + mrow) * 6144;
            __syncthreads();
            if (F.tid < 256) *(LAS f32x4*)(gl + 4 * F.tid) = *(const f32x4*)(i_norm2_g + l * D + 4 * F.tid) * (*(const f32x4*)(mod + 4096 + 4 * F.tid) + 1.0f);
            else *(LAS f32x4*)(gl + 1024 + 4 * (F.tid - 256)) = *(const f32x4*)(mod + 3072 + 4 * (F.tid - 256));
            __syncthreads(); }
#pragma unroll
        for (int i = 0; i < RB; ++i) { const int r = r0 + i;
            float ss = 0.f;
#pragma unroll
            for (int j = 0; j < 4; ++j) { const u32x2 dw = dl[i][j]; const u32x2 xw = xr[i][j]; const f32x4 xin = (l == 0) ? xv[i][j] : (f32x4){blo(xw.x), bhi(xw.x), blo(xw.y), bhi(xw.y)};
                const f32x4 x = xin + (f32x4){blo(dw.x), bhi(dw.x), blo(dw.y), bhi(dw.y)}; xv[i][j] = x;
                { u32x2 xo; xo.x = pk2(x.x, x.y); xo.y = pk2(x.z, x.w); *(u32x2*)(gXb + (size_t)r * D + 4 * F.lane + 256 * j) = xo; }
                ss += (x.x * x.x + x.y * x.y) + (x.z * x.z + x.w * x.w); }
            const float rs = rsqrtf(wave_sum(ss) * (1.0f / D) + EPS);
#pragma unroll
            for (int j = 0; j < 4; ++j) { const int c0 = 4 * F.lane + 256 * j;
                const f32x4 o = xv[i][j] * rs * *(const LAS f32x4*)(gl + c0) + *(const LAS f32x4*)(gl + 1024 + c0);
                if (FP8_MOE1) *(unsigned*)(gA8 + (size_t)r * D + c0) = pk4_fp8(o.x, o.y, o.z, o.w);
                else { u32x2 w; w.x = pk2(o.x, o.y); w.y = pk2(o.z, o.w); *(u32x2*)(gA + (size_t)r * D + c0) = w; }
                *(LAS f32x4*)(hrow + (F.wave * RB + i) * HP + c0) = o; }
            asm volatile("" ::: "memory"); __builtin_amdgcn_sched_barrier(0); }
        if (wb + 1 < wb_hi) ROUTE_LOADX(xv, wb + 1);
        __builtin_amdgcn_sched_barrier(0);
        __syncthreads();
        { f32x4 acc[4];
#pragma unroll
          for (int et = 0; et < 4; ++et) acc[et] = (f32x4){0.f, 0.f, 0.f, 0.f};
#define ROUTE_STEP(slot, ks_) do { const int k8 = F.wave * 128 + (ks_) * 32 + kq; \
              const f32x4 x0 = *(const LAS f32x4*)(hrow + ar * HP + k8), x1 = *(const LAS f32x4*)(hrow + ar * HP + k8 + 4); \
              u32x4 hw, lw; \
              hw.x = pk2(x0.x, x0.y); hw.y = pk2(x0.z, x0.w); hw.z = pk2(x1.x, x1.y); hw.w = pk2(x1.z, x1.w); \
              lw.x = pk2(x0.x - blo(hw.x), x0.y - bhi(hw.x)); lw.y = pk2(x0.z - blo(hw.y), x0.w - bhi(hw.y)); lw.z = pk2(x1.x - blo(hw.z), x1.y - bhi(hw.z)); lw.w = pk2(x1.z - blo(hw.w), x1.w - bhi(hw.w)); \
              const bf16x8 ah = __builtin_bit_cast(bf16x8, hw), al = __builtin_bit_cast(bf16x8, lw); \
              _Pragma("unroll") for (int et = 0; et < 4; ++et) { const bf16x8 bh = wfh[slot][et], bl = wfl[slot][et]; \
                  acc[et] = __builtin_amdgcn_mfma_f32_16x16x32_bf16(ah, bh, acc[et], 0, 0, 0); \
                  acc[et] = __builtin_amdgcn_mfma_f32_16x16x32_bf16(al, bh, acc[et], 0, 0, 0); \
                  acc[et] = __builtin_amdgcn_mfma_f32_16x16x32_bf16(ah, bl, acc[et], 0, 0, 0); } } while (0)
          ROUTE_STEP(0, 0); __builtin_amdgcn_sched_barrier(0); ROUTE_LOADW(0, 2); __builtin_amdgcn_sched_barrier(0);
          ROUTE_STEP(1, 1); __builtin_amdgcn_sched_barrier(0); ROUTE_LOADW(1, 3); __builtin_amdgcn_sched_barrier(0);
          ROUTE_STEP(0, 2); __builtin_amdgcn_sched_barrier(0); ROUTE_STEP(1, 3); __builtin_amdgcn_sched_barrier(0);
          if (wb + 1 < wb_hi) { ROUTE_LOADW(0, 0); ROUTE_LOADW(1, 1); }
          __builtin_amdgcn_sched_barrier(0);
#undef ROUTE_STEP
#pragma unroll
          for (int et = 0; et < 4; ++et)
#pragma unroll
              for (int j = 0; j < 4; ++j) part[(F.wave * 16 + (F.lane >> 4) * 4 + j) * 68 + et * 16 + ar] = acc[et][j]; }
        __syncthreads();
        { float score[RB], sel[RB], gcur[RB], cur[RB]; bool gsel[RB]; int erk[RB];
#pragma unroll
          for (int i = 0; i < RB; ++i) { float lgt = 0.f;
#pragma unroll
            for (int w = 0; w < 8; ++w) lgt += part[(w * 16 + F.wave * RB + i) * 68 + F.lane];
            score[i] = sigmoidf_(lgt); sel[i] = score[i] + rbias;
            const float m1 = oct_max(sel[i]);
            const unsigned long long e1 = __ballot(sel[i] == m1);
            const int w1 = __builtin_ctz((unsigned)((e1 >> (F.lane & ~7)) & 0xFFull));
            const float m2 = oct_max(((F.lane & 7) == w1) ? -INFINITY : sel[i]);
            gcur[i] = m1 + m2; gsel[i] = false; }
#pragma unroll 1
          for (int k = 0; k < 4; ++k) {
#pragma unroll
            for (int i = 0; i < RB; ++i) { const float mx = wave_max(gcur[i]); const unsigned long long bm = __ballot(gcur[i] == mx); const int wg_ = __builtin_ctzll(bm) >> 3;
                if ((F.lane >> 3) == wg_) { gsel[i] = true; gcur[i] = -INFINITY; } } }
#pragma unroll
          for (int i = 0; i < RB; ++i) { cur[i] = gsel[i] ? sel[i] : -INFINITY; erk[i] = 8; }
#pragma unroll 1
          for (int k = 0; k < TOPK; ++k) {
#pragma unroll
            for (int i = 0; i < RB; ++i) { const float mx = wave_max(cur[i]);
                const unsigned long long bm = __ballot(cur[i] == mx); const int win = __builtin_ctzll(bm);
                if (F.lane == win) { erk[i] = k; cur[i] = -INFINITY; } } }
#pragma unroll
          for (int i = 0; i < RB; ++i) { const int r = r0 + i;
            const bool chosen = erk[i] < 8;
            const float wsum = wave_sum(chosen ? score[i] : 0.f);
            if (chosen) { const unsigned li = __hip_atomic_fetch_add(wcnt + F.lane, 1u, __ATOMIC_RELAXED, __HIP_MEMORY_SCOPE_WORKGROUP);
                gEIDX[r * 8 + erk[i]] = F.lane; gEW[r * 8 + erk[i]] = score[i] / wsum * 2.5f; ent[((wb - wb_lo) * WROWS + F.wave * RB + i) * 8 + erk[i]] = (unsigned)F.lane | (li << 8); } }
        }
        __syncthreads();
    }
#undef ROUTE_LOADX
#undef ROUTE_LOADW
    __syncthreads();
    if (F.tid < 64) { const unsigned c = wcnt[F.tid]; wbase[F.tid] = c ? __hip_atomic_fetch_add(fill + F.tid, c, RLX_AGENT) : 0u; }
    __syncthreads();
    const int nmine = (wb_hi - wb_lo) * WROWS, row_lo = wb_lo * WROWS;
    for (int idx = F.tid; idx < nmine * 8; idx += NTHR) { const unsigned v = ent[idx]; const int e = (int)(v & 255u); const unsigned q = wbase[e] + (v >> 8); const int row = row_lo + (idx >> 3);
        gSPOS[row * 8 + (idx & 7)] = (int)q; gRT2[(size_t)e * RCAP + q] = row; }
    for (int lr = F.tid; lr < nmine; lr += NTHR) gRT2[(size_t)NE * RCAP + row_lo + lr] = row_lo + lr;
}
__device__ __forceinline__ void ph_scatter(Frame& F, int g, int l) {
    const int nrows = (l == 0) ? R : RL;
    unsigned* fill = gCTL + CW_CNT + (g * DEPTH + l) * 128 + 64;
    const unsigned c = __hip_atomic_load(fill + F.lane, RLX_AGENT), pad = (c + 255u) & ~255u;
    unsigned incl = pad;
#pragma unroll
    for (int o = 1; o < 64; o <<= 1) { const unsigned t = __shfl_up(incl, o); if (F.lane >= o) incl += t; }
    const unsigned off = incl - pad;
    const long total = (long)nrows * 8;
    const long iters = (total + F.nthr - 1) / F.nthr;
    for (long k = 0; k < iters; ++k) {
        const long it = k * F.nthr + F.gtid; const bool act = it < total;
        const int e = act ? gEIDX[it] : 0;
        const unsigned base = __shfl(off, e);
        if (act) { const int row = (int)(it >> 3); const int nbatch_ = nrows / WROWS; const int wg = (int)((((long)(row / WROWS) + 1) * F.G - 1) / nbatch_);
            const unsigned pos = base + gWGBASE[wg * 64 + e] + (unsigned)gSPOS[it]; gROWTOK[pos] = row; gROWW[pos] = gEW[it]; gSPOS[it] = (int)pos; }
    }
    const unsigned ntr = __shfl(incl, 63) / 256u;
    for (int r = F.gtid; r < nrows; r += F.nthr) { gROWTOK[ntr * 256u + r] = r; gROWW[ntr * 256u + r] = 1.0f; }
    if (F.wave == 0) for (int e = (int)blockIdx.x; e < NE; e += F.G) {
        const unsigned ce = __shfl(c, e), pade = __shfl(pad, e), offe = __shfl(off, e);
        for (unsigned p = ce + F.lane; p < pade; p += 64u) { gROWTOK[offe + p] = 0; gROWW[offe + p] = 0.f; }
        for (unsigned t = F.lane; t < pade / 256u; t += 64u) gTILEE[offe / 256u + t] = e;
    }
    if ((int)blockIdx.x == F.G - 1 && F.wave == 0) {
        if (F.lane < nrows / 256) gTILEE[ntr + F.lane] = NE;
        if (F.lane == 63) { gNT[0] = (int)ntr + nrows / 256; gNT[1] = (int)ntr; }
    }
}
__device__ __forceinline__ void ph_moe1_naive(Frame& F, int l) {
    const int nt = gNT[0]; const int nq = EFF / 4; const long tot = (long)(nt * 256 / 4) * nq;
    for (long it = F.gtid; it < tot; it += F.nthr) {
        const int rq = (int)(it / nq), cq = (int)(it % nq), r0 = rq * 4, c0 = cq * 4;
        const int e = gTILEE[r0 >> 8];
        const float* Wg = e < NE ? (i_ew_gate + ((size_t)l * NE + e) * D * EFF) : (i_sw_gate + (size_t)l * D * EFF);
        const float* Wu = e < NE ? (i_ew_up + ((size_t)l * NE + e) * D * EFF) : (i_sw_up + (size_t)l * D * EFF);
        const bf16 *a0 = gA + (size_t)gROWTOK[r0] * D, *a1 = gA + (size_t)gROWTOK[r0 + 1] * D, *a2 = gA + (size_t)gROWTOK[r0 + 2] * D, *a3 = gA + (size_t)gROWTOK[r0 + 3] * D;
        float ag[4][4], au[4][4]; ZERO44(ag); ZERO44(au);
        ngemm_acc(ag, a0, a1, a2, a3, Wg, EFF, c0, D);
        ngemm_acc(au, a0, a1, a2, a3, Wu, EFF, c0, D);
#pragma unroll
        for (int i = 0; i < 4; ++i) { float o[4]; const float w = gROWW[r0 + i];
#pragma unroll
            for (int j = 0; j < 4; ++j) { const float gv = ag[i][j]; o[j] = w * (gv / (1.0f + __expf(-gv))) * au[i][j]; }
            u32x2 q; q.x = pk2(o[0], o[1]); q.y = pk2(o[2], o[3]); *(u32x2*)(gH + (size_t)(r0 + i) * EFF + c0) = q; }
    }
}
__device__ __forceinline__ void ph_moe2_naive(Frame& F, int l) {
    const int nt = gNT[0]; const int nq = D / 4; const long tot = (long)(nt * 256 / 4) * nq;
    for (long it = F.gtid; it < tot; it += F.nthr) {
        const int rq = (int)(it / nq), cq = (int)(it % nq), r0 = rq * 4, c0 = cq * 4;
        const int e = gTILEE[r0 >> 8];
        const bf16* a = gH + (size_t)r0 * EFF;
        const float* Wd = e < NE ? (i_ew_down + ((size_t)l * NE + e) * EFF * D) : (i_sw_down + (size_t)l * EFF * D);
        float acc[4][4]; ZERO44(acc);
        ngemm_acc(acc, a, a + EFF, a + 2 * EFF, a + 3 * EFF, Wd, D, c0, EFF);
#pragma unroll
        for (int i = 0; i < 4; ++i) { u32x2 q; q.x = pk2(acc[i][0], acc[i][1]); q.y = pk2(acc[i][2], acc[i][3]); *(u32x2*)(gYP + (size_t)(r0 + i) * D + c0) = q; }
    }
}

typedef float f32x16 __attribute__((ext_vector_type(16)));
constexpr int NCHK = 36, NSEQ = GB * 4 * 2, LDP = 72;
__device__ __forceinline__ int crow16(int i, int hi) { return (i & 3) + 8 * (i >> 2) + 4 * hi; }
__device__ __forceinline__ f32x16 mma32(f32x16 acc, const LAS bf16* A, int lda, const LAS bf16* Bt, int ldb, int K16, int lane) {
    const int r = lane & 31, hi = lane >> 5;
    for (int ks = 0; ks < K16; ++ks) {
        const bf16x8 a = *(const LAS bf16x8*)(A + r * lda + ks * 16 + hi * 8), b = *(const LAS bf16x8*)(Bt + r * ldb + ks * 16 + hi * 8);
        acc = __builtin_amdgcn_mfma_f32_32x32x16_bf16(a, b, acc, 0, 0, 0);
    }
    return acc;
}
template <bool SWA, bool SWB>
__device__ __forceinline__ f32x16 mma32x(f32x16 acc, const LAS bf16* A, int lda, int ga, const LAS bf16* Bt, int ldb, int gb, int K16, int lane) {
    const int r = lane & 31, hi = lane >> 5;
    for (int ks = 0; ks < K16; ++ks) { const int kb = ks * 2 + hi;
        const bf16x8 a = *(const LAS bf16x8*)(A + r * lda + (SWA ? (kb ^ ga) : kb) * 8), b = *(const LAS bf16x8*)(Bt + r * ldb + (SWB ? (kb ^ gb) : kb) * 8);
        acc = __builtin_amdgcn_mfma_f32_32x32x16_bf16(a, b, acc, 0, 0, 0);
    }
    return acc;
}
__device__ __forceinline__ float log_sigmoidf_(float x) { return fminf(x, 0.f) - __logf(1.0f + __expf(-fabsf(x))); }
__device__ __forceinline__ int mchunk_row(int bl, int dir, int jc) {
    if (jc < 4) return RL + bl * CTXL + (dir ? 3 - jc : jc) * 64;
    const int c = jc - 4; return bl * SEQ + (dir ? 31 - c : c) * 64;
}
template <int CTRL, int ROWMASK> __device__ __forceinline__ float dpp_z(float v) {
    return __int_as_float(__builtin_amdgcn_update_dpp(0, __float_as_int(v), CTRL, ROWMASK, 0xF, true)); }
__device__ __forceinline__ void mgates(const bf16* P, int rb, int h, int dir, int l, const float* gate_b, int lane, int& tk, float& b, float& total, float& ig) {
    tk = dir ? 63 - lane : lane;
    const bf16* row = P + (size_t)(rb + tk) * PSTR + OGM;
    ig = bf2f(row[(dir * 2) * 4 + h]) + gate_b[l * 16 + (dir * 2) * 4 + h];
    const float fg = bf2f(row[(dir * 2 + 1) * 4 + h]) + gate_b[l * 16 + (dir * 2 + 1) * 4 + h];
    b = log_sigmoidf_(fg);
    b += dpp_z<0x111, 0xF>(b); b += dpp_z<0x112, 0xF>(b); b += dpp_z<0x114, 0xF>(b); b += dpp_z<0x118, 0xF>(b);
    b += dpp_z<0x142, 0xA>(b); b += dpp_z<0x143, 0xC>(b);
    total = __int_as_float(__builtin_amdgcn_readlane(__float_as_int(b), 63));
}
#define gDC ((bf16*)(F.ws + WS_HDIR))
#define gDN ((float*)(F.ws + WS_ROUTE + 2 * MiB))
#define gNIN (gDN + NSEQ * NCHK * 64)
#define gDEC (gNIN + NSEQ * NCHK * 64)
#define gCIN ((bf16*)(F.ws + WS_CIN))
__device__ __forceinline__ void ph_mlstm_dc(Frame& F, int l) {
    LAS bf16* VT = (LAS bf16*)F.lds;
    LAS bf16* KwT = VT + 128 * LDP;
    LAS float* wv = (LAS float*)(KwT + 2 * 64 * LDP);
    constexpr int NIT = GB * 4 * NCHK;
    const int nfull_ = NIT / F.G, rem_ = NIT % F.G, nmine_ = nfull_ + ((F.G - 1 - (int)blockIdx.x) < rem_ ? 1 : 0);
    for (int j_ = 0; j_ < nmine_; ++j_) {
        const int item = (j_ < nfull_) ? ((int)blockIdx.x + j_ * F.G) : (nfull_ * F.G + (F.G - 1 - (int)blockIdx.x));
        const int bh = item / NCHK, c = item % NCHK, bl = bh >> 2, h = bh & 3;
        int rb, jc0, jc1;
        if (c < 4) { rb = RL + bl * CTXL + c * 64; jc0 = c; jc1 = 3 - c; } else { const int cc = c - 4; rb = bl * SEQ + cc * 64; jc0 = 4 + cc; jc1 = 4 + 31 - cc; }
        const int it0 = (bl * 8 + h * 2 + 0) * NCHK + jc0, it1 = (bl * 8 + h * 2 + 1) * NCHK + jc1;
        const int t = F.tid >> 3, c8 = F.tid & 7; const bf16* row = gP + (size_t)(rb + t) * PSTR;
        const u32x4 kq = *(const u32x4*)(row + OKM + h * 64 + c8 * 8), v0 = *(const u32x4*)(row + OVM + h * 128 + c8 * 16), v1 = *(const u32x4*)(row + OVM + h * 128 + c8 * 16 + 8);
        if (F.wave < 2) { const int dir = F.wave; int tk; float b, total, ig; mgates(gP, rb, h, dir, l, i_gate_b, F.lane, tk, b, total, ig); wv[dir * 64 + tk] = __expf(total - b + ig); if (F.lane == 0) wv[128 + dir] = __expf(total); }
        __syncthreads();
        { const float w0 = wv[t] * 0.125f, w1 = wv[64 + t] * 0.125f;
#pragma unroll
          for (int e = 0; e < 4; ++e) { const float k0 = blo(kq[e]), k1 = bhi(kq[e]);
              KwT[(c8 * 8 + 2 * e) * LDP + t] = (bf16)f2bf(w0 * k0); KwT[(c8 * 8 + 2 * e + 1) * LDP + t] = (bf16)f2bf(w0 * k1);
              KwT[(64 + c8 * 8 + 2 * e) * LDP + t] = (bf16)f2bf(w1 * k0); KwT[(64 + c8 * 8 + 2 * e + 1) * LDP + t] = (bf16)f2bf(w1 * k1); }
#pragma unroll
          for (int e = 0; e < 4; ++e) { const int tsw = (((t >> 3) ^ c8) << 3) | (t & 7);
                                        VT[(c8 * 16 + 2 * e) * LDP + tsw] = (bf16)(v0[e] & 0xffffu); VT[(c8 * 16 + 2 * e + 1) * LDP + tsw] = (bf16)(v0[e] >> 16);
                                        VT[(c8 * 16 + 8 + 2 * e) * LDP + tsw] = (bf16)(v1[e] & 0xffffu); VT[(c8 * 16 + 8 + 2 * e + 1) * LDP + tsw] = (bf16)(v1[e] >> 16); } }
        __syncthreads();
        { const int e0 = (F.wave >> 1) * 32, d0 = (F.wave & 1) * 32, hi = F.lane >> 5;
#pragma unroll
          for (int dir = 0; dir < 2; ++dir) {
              f32x16 acc = {}; acc = mma32x<true, false>(acc, VT + e0 * LDP, LDP, ((e0 + (F.lane & 31)) >> 4) & 7, KwT + (dir * 64 + d0) * LDP, LDP, 0, 4, F.lane);
              bf16* o = gDC + (size_t)(dir ? it1 : it0) * 8192 + d0 + (F.lane & 31);
#pragma unroll
              for (int i = 0; i < 16; ++i) o[(e0 + crow16(i, hi)) * 64] = (bf16)f2bf(acc[i]); } }
        if (F.wave < 2) { const int dir = F.wave; float s = 0.f;
#pragma unroll 8
            for (int t = 0; t < 64; ++t) s += bf2f(KwT[(dir * 64 + F.lane) * LDP + t]);
            gDN[(dir ? it1 : it0) * 64 + F.lane] = s; if (F.lane == 0) gDEC[dir ? it1 : it0] = wv[128 + dir]; }
        __syncthreads();
    }
}
__device__ __forceinline__ void ph_mlstm_scan(Frame& F) {
    static_assert(NSEQ * 8192 == 2 * 256 * NTHR, "two matrix elements per thread on a 256-workgroup grid");
    const bool two = F.nthr * 2 == NSEQ * 8192;
    if (two) {
        { const int e0 = 2 * F.gtid, s0 = e0 >> 13, c0 = e0 & 8191;
            unsigned x0[NCHK]; float d0[NCHK];
#pragma unroll
            for (int jc = 0; jc < NCHK; ++jc) { d0[jc] = gDEC[s0 * NCHK + jc]; x0[jc] = *(const unsigned*)(gDC + (size_t)(s0 * NCHK + jc) * 8192 + c0); }
            float a0 = 0.f, a1 = 0.f;
#pragma unroll
            for (int jc = 0; jc < NCHK; ++jc) { *(unsigned*)(gCIN + (size_t)(s0 * NCHK + jc) * 8192 + c0) = pk2(a0, a1); a0 = d0[jc] * a0 + blo(x0[jc]); a1 = d0[jc] * a1 + bhi(x0[jc]); } }
        if (F.gtid < NSEQ * 64) { const int sn = F.gtid >> 6, cn = F.gtid & 63; float xn[NCHK], dn[NCHK];
#pragma unroll
            for (int jc = 0; jc < NCHK; ++jc) { dn[jc] = gDEC[sn * NCHK + jc]; xn[jc] = gDN[(sn * NCHK + jc) * 64 + cn]; }
            float c = 0.f;
#pragma unroll
            for (int jc = 0; jc < NCHK; ++jc) { gNIN[(sn * NCHK + jc) * 64 + cn] = c; c = dn[jc] * c + xn[jc]; } }
    } else {
        for (int idx = F.gtid; idx < NSEQ * (8192 + 64); idx += F.nthr) {
            const int seq = idx / (8192 + 64), e = idx % (8192 + 64); const bool isn = e >= 8192; float c = 0.f;
            for (int jc = 0; jc < NCHK; ++jc) { const int item = seq * NCHK + jc;
                if (isn) gNIN[item * 64 + (e - 8192)] = c; else gCIN[(size_t)item * 8192 + e] = (bf16)f2bf(c);
                const float x = isn ? gDN[item * 64 + (e - 8192)] : bf2f(gDC[(size_t)item * 8192 + e]); c = gDEC[item] * c + x; }
        }
    }
}
__device__ __forceinline__ void ph_mlstm_out(Frame& F, int l) {
    LAS bf16* Qs = (LAS bf16*)F.lds;
    LAS bf16* Ks = Qs + 64 * LDP;
    LAS bf16* VT = Ks + 64 * LDP;
    LAS bf16* Sd = VT + 128 * LDP;
    LAS bf16* Ed = Sd + 2 * 64 * LDP;
    LAS bf16* Cd = Ed + 2 * 64 * LDP;
    LAS float* gt = (LAS float*)(Cd + 2 * 128 * LDP);
    LAS float* hb = gt + 5 * 128;
    constexpr int HBP = 132;
    static_assert((64 * LDP * 2 + 128 * LDP + 4 * 64 * LDP + 2 * 128 * LDP) * 2 + 5 * 128 * 4 + 64 * HBP * 4 <= LDS_BYTES - 16, "mlstm_out LDS");
    const int nch = (l == 0) ? 36 : 32;
    const int nitem = GB * 4 * nch;
    const int t = F.tid >> 3, c8 = F.tid & 7, e2 = F.tid >> 2, d16 = (F.tid & 3) * 16;
    u32x4 qq, kq, v0, v1, c00, c01, c10, c11;
#define MO_IDX(item_) const int bh = (item_) / nch, c = (item_) % nch, bl = bh >> 2, h = bh & 3; int rb, jc0, jc1; \
        if (l == 0 && c < 4) { rb = RL + bl * CTXL + c * 64; jc0 = c; jc1 = 3 - c; } else { const int cc = (l == 0) ? c - 4 : c; rb = bl * SEQ + cc * 64; jc0 = 4 + cc; jc1 = 4 + 31 - cc; } \
        const int it0 = (bl * 8 + h * 2 + 0) * NCHK + jc0, it1 = (bl * 8 + h * 2 + 1) * NCHK + jc1;
#define MO_LOAD(item_) do { MO_IDX(item_) const bf16* row = gP + (size_t)(rb + t) * PSTR; \
        qq = *(const u32x4*)(row + OQM + h * 64 + c8 * 8); kq = *(const u32x4*)(row + OKM + h * 64 + c8 * 8); \
        v0 = *(const u32x4*)(row + OVM + h * 128 + c8 * 16); v1 = *(const u32x4*)(row + OVM + h * 128 + c8 * 16 + 8); \
        const bf16* cp0 = gCIN + (size_t)it0 * 8192 + e2 * 64 + d16; const bf16* cp1 = gCIN + (size_t)it1 * 8192 + e2 * 64 + d16; \
        c00 = *(const u32x4*)cp0; c01 = *(const u32x4*)(cp0 + 8); c10 = *(const u32x4*)cp1; c11 = *(const u32x4*)(cp1 + 8); } while (0)
    int item = blockIdx.x; asm volatile("" : "+s"(item));
    if (item < nitem) MO_LOAD(item);
    while (item < nitem) {
        MO_IDX(item)
        if (F.wave < 2) { const int dir = F.wave; int tk; float b, total, ig; mgates(gP, rb, h, dir, l, i_gate_b, F.lane, tk, b, total, ig);
            gt[dir * 64 + tk] = b; gt[128 + dir * 64 + tk] = ig - b; gt[256 + dir * 64 + tk] = __expf(b);
            gt[512 + dir * 64 + F.lane] = gNIN[(dir ? it1 : it0) * 64 + F.lane]; }
        { *(LAS u32x4*)(Qs + t * LDP + c8 * 8) = qq;
          u32x4 ks;
#pragma unroll
          for (int e = 0; e < 4; ++e) ks[e] = pk2(blo(kq[e]) * 0.125f, bhi(kq[e]) * 0.125f);
          *(LAS u32x4*)(Ks + t * LDP + c8 * 8) = ks;
#pragma unroll
          for (int e = 0; e < 4; ++e) { const int tsw = (((t >> 3) ^ c8) << 3) | (t & 7);
                                        VT[(c8 * 16 + 2 * e) * LDP + tsw] = (bf16)(v0[e] & 0xffffu); VT[(c8 * 16 + 2 * e + 1) * LDP + tsw] = (bf16)(v0[e] >> 16);
                                        VT[(c8 * 16 + 8 + 2 * e) * LDP + tsw] = (bf16)(v1[e] & 0xffffu); VT[(c8 * 16 + 8 + 2 * e + 1) * LDP + tsw] = (bf16)(v1[e] >> 16); }
          *(LAS u32x4*)(Cd + e2 * LDP + d16) = c00; *(LAS u32x4*)(Cd + e2 * LDP + d16 + 8) = c01;
          *(LAS u32x4*)(Cd + (128 + e2) * LDP + d16) = c10; *(LAS u32x4*)(Cd + (128 + e2) * LDP + d16 + 8) = c11; }
        const int nxt_item = item + F.G;
        if (nxt_item < nitem) MO_LOAD(nxt_item);
        __syncthreads();
        if (F.wave < 4) {
            const int m0 = (F.wave >> 1) * 32, n0 = (F.wave & 1) * 32, hi = F.lane >> 5, tc = n0 + (F.lane & 31);
            f32x16 acc = {}; acc = mma32(acc, Qs + m0 * LDP, LDP, Ks + n0 * LDP, LDP, 4, F.lane);
            const float cw0 = gt[128 + tc], cw1 = gt[128 + 64 + tc];
#pragma unroll
            for (int i = 0; i < 16; ++i) { const int t = m0 + crow16(i, hi);
                const float a0 = (tc <= t) ? __expf(gt[t] + cw0) : 0.f, a1 = (tc >= t) ? __expf(gt[64 + t] + cw1) : 0.f;
                Sd[t * LDP + tc] = (bf16)f2bf(acc[i] * a0); Sd[(64 + t) * LDP + tc] = (bf16)f2bf(acc[i] * a1); }
        } else {
            const int j = F.tid - 256;
            const int t = j >> 2, d16 = (j & 3) * 16;
#pragma unroll
            for (int dir = 0; dir < 2; ++dir) { const float eb = gt[256 + dir * 64 + t];
#pragma unroll
                for (int q8 = 0; q8 < 2; ++q8) { const u32x4 qq = *(const LAS u32x4*)(Qs + t * LDP + d16 + q8 * 8); u32x4 o;
#pragma unroll
                    for (int e = 0; e < 4; ++e) o[e] = pk2(blo(qq[e]) * eb, bhi(qq[e]) * eb);
                    *(LAS u32x4*)(Ed + (dir * 64 + t) * LDP + d16 + q8 * 8) = o; } }
        }
        __syncthreads();
        {
          const int dir = F.tid >> 8, t = (F.tid >> 2) & 63, part = F.tid & 3; float s = 0.f, qn = 0.f;
#pragma unroll
          for (int q8 = 0; q8 < 2; ++q8) { const u32x4 sv = *(const LAS u32x4*)(Sd + (dir * 64 + t) * LDP + part * 16 + q8 * 8), qv = *(const LAS u32x4*)(Qs + t * LDP + part * 16 + q8 * 8);
#pragma unroll
              for (int e = 0; e < 4; ++e) { s += blo(sv[e]) + bhi(sv[e]); qn += blo(qv[e]) * gt[512 + dir * 64 + part * 16 + q8 * 8 + 2 * e] + bhi(qv[e]) * gt[512 + dir * 64 + part * 16 + q8 * 8 + 2 * e + 1]; } }
          s += gt[256 + dir * 64 + t] * qn; s += __shfl_xor(s, 1); s += __shfl_xor(s, 2);
          if (part == 0) gt[384 + dir * 64 + t] = __builtin_amdgcn_rcpf(fmaxf(fabsf(s), 1.0f)); }
        f32x16 a0 = {}, a1 = {};
        const int m0 = (F.wave >> 2) * 32, n0 = (F.wave & 3) * 32;
        const int gvt = ((n0 + (F.lane & 31)) >> 4) & 7;
        a0 = mma32x<false, true>(a0, Sd + m0 * LDP, LDP, 0, VT + n0 * LDP, LDP, gvt, 4, F.lane); a0 = mma32(a0, Ed + m0 * LDP, LDP, Cd + n0 * LDP, LDP, 4, F.lane);
        a1 = mma32x<false, true>(a1, Sd + (64 + m0) * LDP, LDP, 0, VT + n0 * LDP, LDP, gvt, 4, F.lane); a1 = mma32(a1, Ed + (64 + m0) * LDP, LDP, Cd + (128 + n0) * LDP, LDP, 4, F.lane);
        __syncthreads();
        { const int hi = F.lane >> 5, e = n0 + (F.lane & 31);
#pragma unroll
          for (int i = 0; i < 16; ++i) { const int t = m0 + crow16(i, hi);
              hb[t * HBP + e] = a0[i] * gt[384 + t] + a1[i] * gt[384 + 64 + t]; } }
        __syncthreads();
        { const int t = F.tid >> 3, sg = F.tid & 7; float hv[16]; float ss = 0.f;
#pragma unroll
          for (int q4 = 0; q4 < 4; ++q4) { const f32x4 x = *(const LAS f32x4*)(hb + t * HBP + sg * 16 + q4 * 4); hv[q4 * 4] = x.x; hv[q4 * 4 + 1] = x.y; hv[q4 * 4 + 2] = x.z; hv[q4 * 4 + 3] = x.w; ss += (x.x * x.x + x.y * x.y) + (x.z * x.z + x.w * x.w); }
          ss += __shfl_xor(ss, 1); ss += __shfl_xor(ss, 2); ss += __shfl_xor(ss, 4);
          const float rs = rsqrtf(ss * (1.0f / 128.0f) + EPS);
          const bf16* orow = gP + (size_t)(rb + t) * PSTR + OOM + h * 128 + sg * 16; const float* gn = i_mnorm_g + l * 512 + h * 128 + sg * 16;
          bf16* yo = gYMLS + (size_t)(rb + t) * YCS + h * 128 + sg * 16;
          unsigned char* yo8 = (unsigned char*)gYATT + (size_t)(rb + t) * YCS + 512 + h * 128 + sg * 16;
#pragma unroll
          for (int q8 = 0; q8 < 2; ++q8) { const u32x4 ov = *(const u32x4*)(orow + q8 * 8); float yv[8];
#pragma unroll
              for (int e = 0; e < 4; ++e) { const int k = q8 * 8 + 2 * e; yv[2 * e] = sigmoidf_(blo(ov[e])) * hv[k] * rs * gn[k]; yv[2 * e + 1] = sigmoidf_(bhi(ov[e])) * hv[k + 1] * rs * gn[k + 1]; }
              if (FP8_MRG_L(l)) { u32x2 w8; w8.x = pk4_fp8(yv[0], yv[1], yv[2], yv[3]); w8.y = pk4_fp8(yv[4], yv[5], yv[6], yv[7]); *(u32x2*)(yo8 + q8 * 8) = w8; }
              else { u32x4 w; w.x = pk2(yv[0], yv[1]); w.y = pk2(yv[2], yv[3]); w.z = pk2(yv[4], yv[5]); w.w = pk2(yv[6], yv[7]); *(u32x4*)(yo + q8 * 8) = w; } } }
        __syncthreads();
        item = nxt_item;
    }
#undef MO_IDX
#undef MO_LOAD
}

__device__ __forceinline__ void ph_attn_mfma(Frame& F, int l) {
    LAS bf16* Kb = (LAS bf16*)F.lds;
    LAS bf16* Vb = Kb + 2 * 64 * LDP;
    constexpr float L2E = 1.4426950408889634f;
    const int nlat = GB * 2 * 32, nctx = (l == 0) ? GB * 2 * 4 : 0;
    const int hi = F.lane >> 5, ql = F.lane & 31;
    for (int item = blockIdx.x; item < nlat + nctx; item += F.G) {
        const bool isctx = item >= nlat;
        int bl, kvh, q0, qrow0, ntile;
        if (!isctx) { bl = item >> 6; kvh = (item >> 5) & 1; q0 = (item & 31) * 64; qrow0 = bl * SEQ + q0; ntile = 9; }
        else { const int j = item - nlat; bl = j >> 3; kvh = (j >> 2) & 1; q0 = (j & 3) * 64; qrow0 = RL + bl * CTXL + q0; ntile = 4; }
        const int hq = kvh * 4 + (F.wave >> 1), qi = (F.wave & 1) * 32 + ql, qr = qrow0 + qi;
        bf16x8 qf[4];
        { const bf16* qp = gP + (size_t)qr * PSTR + OQA + hq * 64 + hi * 8;
#pragma unroll
          for (int ks = 0; ks < 4; ++ks) { const u32x4 w = *(const u32x4*)(qp + ks * 16); u32x4 o;
#pragma unroll
              for (int e = 0; e < 4; ++e) o[e] = pk2(blo(w[e]) * (0.125f * L2E), bhi(w[e]) * (0.125f * L2E));
              qf[ks] = __builtin_bit_cast(bf16x8, o); } }
        float m = i_attn_sink[l * 8 + hq] * L2E, lsum = (hi == 0) ? 1.0f : 0.0f;
        f32x16 O0 = {}, O1 = {};
        const int lk = F.tid >> 3, c8 = F.tid & 7;
        u32x4 kreg, vreg;
#define ATT_LOAD(j) do { int row_; if ((j) < 4) row_ = RL + bl * CTXL + (j) * 64 + lk; else { int kp_ = q0 - 128 + ((j) - 4) * 64 + lk; kp_ = kp_ < 0 ? 0 : (kp_ > SEQ - 1 ? SEQ - 1 : kp_); row_ = bl * SEQ + kp_; } \
        const bf16* rp_ = gP + (size_t)row_ * PSTR + kvh * 64 + c8 * 8; kreg = *(const u32x4*)(rp_ + OKA); vreg = *(const u32x4*)(rp_ + OVA); } while (0)
#define ATT_STORE(buf) do { *(LAS u32x4*)(Kb + ((buf) * 64 + lk) * LDP + c8 * 8) = kreg; \
        _Pragma("unroll") for (int e_ = 0; e_ < 4; ++e_) { Vb[((buf) * 64 + c8 * 8 + 2 * e_) * LDP + lk] = (bf16)(vreg[e_] & 0xffffu); Vb[((buf) * 64 + c8 * 8 + 2 * e_ + 1) * LDP + lk] = (bf16)(vreg[e_] >> 16); } } while (0)
        ATT_LOAD(0); ATT_STORE(0);
        __syncthreads();
        for (int j = 0; j < ntile; ++j) {
            const int buf = j & 1;
            if (j + 1 < ntile) ATT_LOAD(j + 1);
            const LAS bf16* kb = Kb + buf * 64 * LDP; const LAS bf16* vb = Vb + buf * 64 * LDP;
            f32x16 S0 = {}, S1 = {};
#pragma unroll
            for (int ks = 0; ks < 4; ++ks) {
                const bf16x8 a0 = *(const LAS bf16x8*)(kb + ql * LDP + ks * 16 + hi * 8), a1 = *(const LAS bf16x8*)(kb + (32 + ql) * LDP + ks * 16 + hi * 8);
                S0 = __builtin_amdgcn_mfma_f32_32x32x16_bf16(a0, qf[ks], S0, 0, 0, 0); S1 = __builtin_amdgcn_mfma_f32_32x32x16_bf16(a1, qf[ks], S1, 0, 0, 0);
            }
            if (j >= 4) {
                const int kbase = q0 - 128 + (j - 4) * 64;
                const bool oob = kbase < 0 || kbase >= SEQ;
                if (oob || j == 4 || j == 8) {
                    const int lo = (oob ? 64 : (j == 4 ? qi : 0)) - 4 * hi, up = ((!oob && j == 8) ? qi : 63) - 4 * hi;
#pragma unroll
                    for (int i = 0; i < 16; ++i) { const int ci = (i & 3) + 8 * (i >> 2);
                        if (ci < lo || ci > up) S0[i] = -INFINITY;
                        if (ci + 32 < lo || ci + 32 > up) S1[i] = -INFINITY; } }
            }
            float mx = fmaxf(S0[0], S1[0]);
#pragma unroll
            for (int i = 1; i < 16; ++i) mx = fmaxf(mx, fmaxf(S0[i], S1[i]));
            { auto rr_ = __builtin_amdgcn_permlane32_swap(__float_as_uint(mx), __float_as_uint(mx), false, false); mx = fmaxf(__uint_as_float(rr_[0]), __uint_as_float(rr_[1])); }
            const float mn = fmaxf(m, mx), corr = __builtin_amdgcn_exp2f(m - mn); const bool grew = __any(mn > m); m = mn;
            float ps = 0.f;
#pragma unroll
            for (int i = 0; i < 16; ++i) { S0[i] = __builtin_amdgcn_exp2f(S0[i] - mn); S1[i] = __builtin_amdgcn_exp2f(S1[i] - mn); ps += S0[i] + S1[i]; }
            lsum = lsum * corr + ps;
            if (grew) {
#pragma unroll
            for (int i = 0; i < 16; ++i) { O0[i] *= corr; O1[i] *= corr; } }
#pragma unroll
            for (int sub = 0; sub < 2; ++sub)
#pragma unroll
                for (int jj = 0; jj < 2; ++jj) {
                    u32x4 pw;
#pragma unroll
                    for (int e = 0; e < 4; ++e) pw[e] = sub ? pk2(S1[8 * jj + 2 * e], S1[8 * jj + 2 * e + 1]) : pk2(S0[8 * jj + 2 * e], S0[8 * jj + 2 * e + 1]);
                    const bf16x8 pf = __builtin_bit_cast(bf16x8, pw);
                    const int kk = sub * 32 + jj * 16 + 4 * hi;
                    u32x2 va0 = *(const LAS u32x2*)(vb + ql * LDP + kk), va1 = *(const LAS u32x2*)(vb + ql * LDP + kk + 8);
                    u32x2 vb0 = *(const LAS u32x2*)(vb + (32 + ql) * LDP + kk), vb1 = *(const LAS u32x2*)(vb + (32 + ql) * LDP + kk + 8);
                    const bf16x8 af0 = __builtin_bit_cast(bf16x8, (u32x4){va0.x, va0.y, va1.x, va1.y}), af1 = __builtin_bit_cast(bf16x8, (u32x4){vb0.x, vb0.y, vb1.x, vb1.y});
                    O0 = __builtin_amdgcn_mfma_f32_32x32x16_bf16(af0, pf, O0, 0, 0, 0); O1 = __builtin_amdgcn_mfma_f32_32x32x16_bf16(af1, pf, O1, 0, 0, 0);
                }
            if (j + 1 < ntile) ATT_STORE((j + 1) & 1);
            __syncthreads();
        }
#undef ATT_LOAD
#undef ATT_STORE
        { auto rr_ = __builtin_amdgcn_permlane32_swap(__float_as_uint(lsum), __float_as_uint(lsum), false, false); lsum = __uint_as_float(rr_[0]) + __uint_as_float(rr_[1]); }
        const float inv = 1.0f / lsum;
        if (FP8_MRG_L(l)) { unsigned char* op8 = (unsigned char*)gYATT + (size_t)qr * YCS + hq * 64 + 4 * hi;
#pragma unroll
            for (int g4 = 0; g4 < 4; ++g4) { *(unsigned*)(op8 + 8 * g4) = pk4_fp8(O0[4 * g4] * inv, O0[4 * g4 + 1] * inv, O0[4 * g4 + 2] * inv, O0[4 * g4 + 3] * inv);
                *(unsigned*)(op8 + 32 + 8 * g4) = pk4_fp8(O1[4 * g4] * inv, O1[4 * g4 + 1] * inv, O1[4 * g4 + 2] * inv, O1[4 * g4 + 3] * inv); } }
        else {
        bf16* op = gYATT + (size_t)qr * YCS + hq * 64 + 4 * hi;
#pragma unroll
        for (int g4 = 0; g4 < 4; ++g4) {
            u32x2 w0, w1; w0.x = pk2(O0[4 * g4] * inv, O0[4 * g4 + 1] * inv); w0.y = pk2(O0[4 * g4 + 2] * inv, O0[4 * g4 + 3] * inv);
            w1.x = pk2(O1[4 * g4] * inv, O1[4 * g4 + 1] * inv); w1.y = pk2(O1[4 * g4 + 2] * inv, O1[4 * g4 + 3] * inv);
            *(u32x2*)(op + 8 * g4) = w0; *(u32x2*)(op + 32 + 8 * g4) = w1; } }
    }
}

#define WB_PTR(l, off) ((bf16*)(F.ws + WS_WB + (size_t)(l) * WB_LAYER + (off)))
template <int ES, class RowMap, int NP = 2>
__device__ __forceinline__ void transpose_item(const float* W, int K, int Nsrc, void* dstv, int ldd, const RowMap& rm, LAS float* scr, int kb, int nb, int lane, float scale = 1.0f) {
    const int k0 = 64 * kb;
    f32x4 wv[NP][8];
#pragma unroll
    for (int p = 0; p < NP; ++p) { const int n4 = 32 * (nb + p) + (lane & 7) * 4;
#pragma unroll
      for (int i = 0; i < 8; ++i) { const int kk = 8 * i + (lane >> 3);
          f32x4 w4 = (f32x4){0.f, 0.f, 0.f, 0.f};
          if (n4 + 3 < Nsrc) w4 = *(const f32x4*)(W + (size_t)(k0 + kk) * Nsrc + n4);
          else { if (n4 < Nsrc) w4.x = W[(size_t)(k0 + kk) * Nsrc + n4]; if (n4 + 1 < Nsrc) w4.y = W[(size_t)(k0 + kk) * Nsrc + n4 + 1]; if (n4 + 2 < Nsrc) w4.z = W[(size_t)(k0 + kk) * Nsrc + n4 + 2]; }
          wv[p][i] = w4; } }
    const int c = lane & 7;
#pragma unroll
    for (int p = 0; p < NP; ++p) { const int n0 = 32 * (nb + p);
#pragma unroll
      for (int i = 0; i < 8; ++i) { const int kk = 8 * i + (lane >> 3); const f32x4 w4 = wv[p][i];
          LAS float* d = scr + kk * 33 + (lane & 7) * 4; d[0] = w4.x * scale; d[1] = w4.y * scale; d[2] = w4.z * scale; d[3] = w4.w * scale; }
      asm volatile("s_waitcnt lgkmcnt(0)" ::: "memory");
#pragma unroll
      for (int j = 0; j < 4; ++j) { const int n = (lane >> 3) + 8 * j; const LAS float* sp = scr + (8 * c) * 33 + n;
        if constexpr (ES == 2) { u32x4 o; o.x = pk2(sp[0 * 33], sp[1 * 33]); o.y = pk2(sp[2 * 33], sp[3 * 33]); o.z = pk2(sp[4 * 33], sp[5 * 33]); o.w = pk2(sp[6 * 33], sp[7 * 33]);
            *(u32x4*)((bf16*)dstv + (size_t)rm(n0 + n) * ldd + k0 + 8 * c) = o; }
        else { u32x2 o; o.x = pk4_fp8(sp[0 * 33], sp[1 * 33], sp[2 * 33], sp[3 * 33]); o.y = pk4_fp8(sp[4 * 33], sp[5 * 33], sp[6 * 33], sp[7 * 33]);
            *(u32x2*)((unsigned char*)dstv + (size_t)rm(n0 + n) * ldd + k0 + 8 * c) = o; } }
      asm volatile("s_waitcnt lgkmcnt(0)" ::: "memory"); }
}
struct RmId { __device__ __forceinline__ int operator()(int n) const { return n; } };
struct RmGU { int up; __device__ __forceinline__ int operator()(int n) const { return (n >> 7) * 256 + up * 128 + (n & 127); } };
constexpr int I_WIN = 16 * 224, I_WOUT = 16 * 32, I_WBR = 3 * 8 * 32, I_GU = 65 * 16 * 8, I_DN = 65 * 4 * 32, I_LAYER = I_WIN + I_WOUT + I_WBR + 2 * I_GU + I_DN;
#ifndef CONV_PCT0
#define CONV_PCT0 44
#endif
#ifndef CONV_PCT5
#define CONV_PCT5 42
#endif
constexpr int CONV_P0 = I_LAYER + ((I_LAYER * CONV_PCT0) / 100 & ~1), CONV_SPLIT = CONV_P0 + ((I_LAYER * CONV_PCT5) / 100 & ~1);
__device__ __forceinline__ void ph_convert_weights(Frame& F, int it_lo, int it_hi, int worker, int nworker) {
    LAS float* scr = (LAS float*)(F.lds + F.wave * 16384);
    static_assert(I_LAYER % 2 == 0 && CONV_SPLIT % 2 == 0 && CONV_P0 % 2 == 0 && CONV_SPLIT <= 2 * I_LAYER && I_WIN % 2 == 0 && I_WOUT % 2 == 0 && I_WBR % 2 == 0 && I_GU % 2 == 0, "items go in pairs (two adjacent 32-column blocks)");
        for (int it = it_lo + 2 * worker; it < it_hi; it += 2 * nworker) {
        const int l = it / I_LAYER; int r = it % I_LAYER;
        if (r < I_WIN) { if (FP8_WIN_L(l)) transpose_item<1>(i_w_in + (size_t)l * D * DIN, D, DIN, WB_PTR(l, WB_WIN), D, RmId{}, scr, r / 224, r % 224, F.lane, WIN_SCALE); else transpose_item<2>(i_w_in + (size_t)l * D * DIN, D, DIN, WB_PTR(l, WB_WIN), D, RmId{}, scr, r / 224, r % 224, F.lane, 1.0f); continue; } r -= I_WIN;
        if (r < I_WOUT) { if (FP8_MRG_L(l)) transpose_item<1>(i_w_out + (size_t)l * D * D, D, D, WB_PTR(l, WB_WOUT), D, RmId{}, scr, r / 32, r % 32, F.lane, WOUT_SCALE); else transpose_item<2>(i_w_out + (size_t)l * D * D, D, D, WB_PTR(l, WB_WOUT), D, RmId{}, scr, r / 32, r % 32, F.lane); continue; } r -= I_WOUT;
        if (r < I_WBR) { const int b = r / 256, q = r % 256; const float* src = (b == 0 ? i_w_br0 : b == 1 ? i_w_br1 : i_w_br2) + (size_t)l * 512 * D;
            if (FP8_MRG_L(l)) transpose_item<1>(src, 512, D, (unsigned char*)WB_PTR(l, WB_WBR) + (size_t)b * 512, YCS, RmId{}, scr, q / 32, q % 32, F.lane, WBR_SCALE);
            else transpose_item<2>(src, 512, D, WB_PTR(l, WB_WBR) + (size_t)b * 512, YCS, RmId{}, scr, q / 32, q % 32, F.lane); continue; } r -= I_WBR;
        if (r < 2 * I_GU) { const int up = r >= I_GU; if (up) r -= I_GU; const int e = r / 128, q = r % 128;
            const float* src = e < NE ? ((up ? i_ew_up : i_ew_gate) + ((size_t)l * NE + e) * D * EFF) : ((up ? i_sw_up : i_sw_gate) + (size_t)l * D * EFF);
            transpose_item<FP8_MOE1 ? 1 : 2>(src, D, EFF, (unsigned char*)WB_PTR(l, WB_W1) + (size_t)e * 512 * D * (FP8_MOE1 ? 1 : 2), D, RmGU{up}, scr, q / 8, q % 8, F.lane, FP8_MOE1 ? WIN_SCALE : 1.0f); continue; } r -= 2 * I_GU;
        { const int e = r / 128, q = r % 128; const float* src = e < NE ? (i_ew_down + ((size_t)l * NE + e) * EFF * D) : (i_sw_down + (size_t)l * EFF * D);
            if (FP8_MOE2_L(l)) transpose_item<1>(src, EFF, D, (unsigned char*)WB_PTR(l, WB_W2) + (size_t)e * D * EFF, EFF, RmId{}, scr, q / 32, q % 32, F.lane, W2_SCALE);
            else transpose_item<2>(src, EFF, D, WB_PTR(l, WB_W2) + (size_t)e * D * EFF, EFF, RmId{}, scr, q / 32, q % 32, F.lane); }
    }
}
__device__ __forceinline__ void ph_win_mfma(Frame& F, int l) {
    static_assert(PSTR / 256 == 28 && OBG / 256 == 15 && DIN / 256 == 27, "WinSched's light / heavy column tiles");
    pg8::WinSched S; S.init(R / 256, PSTR / 256, F.G, (int)blockIdx.x);
    pg8::EpiWin E{gP, gROPE, i_bgate_b + (size_t)l * 3 * D, FP8_WIN_L(l) ? 1.0f / WIN_SCALE : 1.0f};
    if (FP8_WIN_L(l)) pg8::gemm_run<pg8::EpiWin, pg8::WinSched, 1>(F.lds, F.tid, (l == 0) ? gA8n : gA8, WB_PTR(l, WB_WIN), D, D, D, S, E);
    else pg8::gemm_run<pg8::EpiWin, pg8::WinSched, 2>(F.lds, F.tid, gA, WB_PTR(l, WB_WIN), D, D, D, S, E);
}
__device__ __forceinline__ void ph_merge_mfma(Frame& F, int l) {
    pg8::MergeSched S; S.init(((l == 0) ? R : RL) / 256, D / 256, F.G, (int)blockIdx.x);
    if (FP8_MRG_L(l) && l == 0) { pg8::DenseSched S1; S1.init(R / 256, D / 256, F.G, (int)blockIdx.x);
        pg8::EpiMerge<2> E{gYMERGE, gP, (unsigned char*)gA  , 1.0f / WBR_SCALE};
        pg8::gemm_run<pg8::EpiMerge<2>, pg8::DenseSched, 1, 2>(F.lds, F.tid, gYATT, WB_PTR(l, WB_WBR), 1536, YCS, YCS, S1, E); }
    else if (FP8_MRG_L(l)) { pg8::DenseSched S1; S1.init(RL / 256, D / (MRG_NB * 128), F.G, (int)blockIdx.x);
        pg8::EpiMerge<MRG_NB> E{gYMERGE, gP, (unsigned char*)gA, 1.0f / WBR_SCALE};
        pg8::gemm_run<pg8::EpiMerge<MRG_NB>, pg8::DenseSched, 1, MRG_NB>(F.lds, F.tid, gYATT, WB_PTR(l, WB_WBR), 1536, YCS, YCS, S1, E); }
    else { pg8::DenseSched S2; S2.init(((l == 0) ? R : RL) / 256, D / 256, F.G, (int)blockIdx.x); pg8::EpiMerge<2> E{gYMERGE, gP, nullptr, 1.0f};
        pg8::gemm_run<pg8::EpiMerge<2>, pg8::DenseSched, 2>(F.lds, F.tid, gYATT, WB_PTR(l, WB_WBR), 1536, YCS, YCS, S2, E); }
}
__device__ __forceinline__ void ph_wout_mfma(Frame& F, int g, int l) {
    pg8::DenseSched S; S.init(((l == 0) ? R : RL) / 256, D / 256, F.G, (int)blockIdx.x);
    if (FP8_MRG_L(l) && l == 0) { pg8::EpiWout<2> E{gH  , gMOD + (size_t)l * 17 * 6144, g, 1.0f / (YM_SCALE * WOUT_SCALE)};
        pg8::gemm_run<pg8::EpiWout<2>, pg8::DenseSched, 1, 2>(F.lds, F.tid, gA, WB_PTR(l, WB_WOUT), D, D, D, S, E); }
    else if (FP8_MRG_L(l)) { pg8::DenseSched S1; S1.init(RL / 256, D / (MRG_NB * 128), F.G, (int)blockIdx.x);
        pg8::EpiWout<MRG_NB> E{gH, gMOD + (size_t)l * 17 * 6144, g, 1.0f / (YM_SCALE * WOUT_SCALE)};
        pg8::gemm_run<pg8::EpiWout<MRG_NB>, pg8::DenseSched, 1, MRG_NB>(F.lds, F.tid, gA, WB_PTR(l, WB_WOUT), D, D, D, S1, E); }
    else { pg8::EpiWout<2> E{gH, gMOD + (size_t)l * 17 * 6144, g, 1.0f};
        pg8::gemm_run<pg8::EpiWout<2>, pg8::DenseSched, 2>(F.lds, F.tid, gYMERGE, WB_PTR(l, WB_WOUT), D, D, D, S, E); }
}
__device__ __forceinline__ int moe_tiles_to_lds(Frame& F, int g, int l) {
    LAS int* te = (LAS int*)(F.lds + pg8::TILEE_OFF); LAS int* toff = te + 512;
    const int nsh = ((l == 0) ? R : RL) / 256;
    if (F.wave == 0) { const unsigned* fill = gCTL + CW_CNT + (g * DEPTH + l) * 128 + 64;
        const int nt = (int)((__hip_atomic_load(fill + F.lane, RLX_AGENT) + 255u) >> 8);
        int incl = nt;
#pragma unroll
        for (int o = 1; o < 64; o <<= 1) { const int t = __shfl_up(incl, o); if (F.lane >= o) incl += t; }
        const int off = incl - nt; toff[F.lane] = off; if (F.lane == 63) toff[64] = incl;
        for (int j = 0; j < nt; ++j) te[off + j] = F.lane;
        const int ntr = __shfl(incl, 63);
        if (F.lane < nsh) te[ntr + F.lane] = NE; }
    asm volatile("s_waitcnt vmcnt(0) lgkmcnt(0)" ::: "memory"); __syncthreads();
    return __builtin_amdgcn_readfirstlane(toff[64]) + nsh;
}
__device__ __forceinline__ void ph_moe1_mfma(Frame& F, int g, int l) {
    const int ntile = moe_tiles_to_lds(F, g, l);
    pg8::MoeSched<2, true> S; S.init(ntile, F.G, (int)blockIdx.x, (const LAS int*)(F.lds + pg8::TILEE_OFF), gRT2);
    pg8::EpiMoe1 E{gH, FP8_MOE2_L(l)};
    if (FP8_MOE1) pg8::gemm_run<pg8::EpiMoe1, pg8::MoeSched<2, true>, 1>(F.lds, F.tid, gA8, WB_PTR(l, WB_W1), D, D, D, S, E);
    else pg8::gemm_run<pg8::EpiMoe1, pg8::MoeSched<2, true>, 2>(F.lds, F.tid, gA, WB_PTR(l, WB_W1), D, D, D, S, E);
}
__device__ __forceinline__ void ph_moe2_mfma(Frame& F, int g, int l) {
    const int ntile = moe_tiles_to_lds(F, g, l);
    pg8::MoeSched<4, false> S; S.init(ntile, F.G, (int)blockIdx.x, (const LAS int*)(F.lds + pg8::TILEE_OFF), nullptr);
#if YP8
    pg8::EpiF8 E{(unsigned char*)gYP, D, FP8_MOE2_L(l) ? YP_SCALE / (H_SCALE * W2_SCALE) : YP_SCALE};
    if constexpr (FP8_MOE2_MASK == 3) pg8::gemm_run<pg8::EpiF8, pg8::MoeSched<4, false>, 1>(F.lds, F.tid, gH, WB_PTR(l, WB_W2), EFF, EFF, EFF, S, E);
    else if constexpr (FP8_MOE2_MASK == 0) pg8::gemm_run<pg8::EpiF8, pg8::MoeSched<4, false>, 2>(F.lds, F.tid, gH, WB_PTR(l, WB_W2), EFF, EFF, EFF, S, E);
    else { if (FP8_MOE2_L(l)) pg8::gemm_run<pg8::EpiF8, pg8::MoeSched<4, false>, 1>(F.lds, F.tid, gH, WB_PTR(l, WB_W2), EFF, EFF, EFF, S, E);
        else pg8::gemm_run<pg8::EpiF8, pg8::MoeSched<4, false>, 2>(F.lds, F.tid, gH, WB_PTR(l, WB_W2), EFF, EFF, EFF, S, E); }
#else
    pg8::EpiBf E{gYP, D};
    pg8::gemm_run<pg8::EpiBf, pg8::MoeSched<4, false>>(F.lds, F.tid, gH, WB_PTR(l, WB_W2), EFF, EFF, EFF, S, E);
#endif
}

constexpr int NPH = 12, NPHASES = 1 + NG * DEPTH * NPH;
__global__ void __launch_bounds__(NTHR, 2) mk_fwd(Args args) {
    extern __shared__ __attribute__((aligned(16))) unsigned char lds_raw[];
#define FRAME() Frame F; { int t_ = threadIdx.x; asm volatile("" : "+v"(t_)); \
    const __attribute__((address_space(4))) Args* ka_ = (const __attribute__((address_space(4))) Args*)__builtin_amdgcn_kernarg_segment_ptr(); asm volatile("" : "+s"(ka_)); \
    F.lds = (LAS unsigned char*)lds_raw; F.tid = t_; F.lane = t_ & 63; F.wave = __builtin_amdgcn_readfirstlane(t_ >> 6); \
    F.G = gridDim.x; F.gtid = blockIdx.x * NTHR + t_; F.nthr = F.G * NTHR; F.gwave = blockIdx.x * NWAVES + F.wave; F.nwave = F.G * NWAVES; F.a = ka_; F.ws = ka_->ws; }
    LAS unsigned char* const ldsb = (LAS unsigned char*)lds_raw;
    const int lo = args.ph_lo, hi = args.ph_hi;
    volatile LAS unsigned* xbst = (volatile LAS unsigned*)(ldsb + LDS_BYTES - 16);
    if (threadIdx.x < 4) xbst[threadIdx.x] = 0u;
    __syncthreads();
    XcdBarrier bar; bar.bar = ((unsigned*)(args.ws + (WS_CTL))) + CW_BAR; bar.x = 0; bar.st = xbst;
    if (hi - lo > 1) bar = xcd_barrier_post(((unsigned*)(args.ws + (WS_CTL))) + CW_BAR, xbst);
#ifdef ONLYK
#define INK(k) ((k) == ONLYK)
#else
#define INK(k) 1
#endif
#define IN(k) (lo <= (k) && (k) < hi)
#define SEAM(k) do { if ((k) + 1 < hi) xcd_barrier(bar); } while (0)
#define DUPBAR(k) if (DUP == (k)) xcd_barrier(bar)

    if (INK(-1) && IN(0)) { FRAME(); ph_prologue(F); __syncthreads(); ph_convert_weights(F, 0, (F.G > R / 256 * 4) ? CONV_P0 : 2 * I_LAYER, F.gwave, F.nwave); SEAM(0); }
    for (int g = 0; g < NG; ++g) {
        { constexpr int l = 0;
            const int b0 = 1 + (g * DEPTH + l) * NPH;
            if (!(b0 + NPH <= lo || b0 >= hi)) {
            if (INK(0) && IN(b0 + 0)) { if (l == 0 && g == 0) { FRAME(); ph_norm1_input(F, g, F.gwave, F.nwave); SEAM(b0 + 0); } }
#if USE_MFMA_WIN
            if (INK(1) && IN(b0 + 1)) { FRAME(); ph_win_mfma(F, l); if (DUP == 1) { xcd_barrier(bar); ph_win_mfma(F, l); } SEAM(b0 + 1); }
#else
            if (INK(1) && IN(b0 + 1)) { FRAME(); ph_win_naive(F, l); SEAM(b0 + 1); }
            if (INK(2) && IN(b0 + 2)) { FRAME(); ph_rope(F); SEAM(b0 + 2); }
#endif
#if USE_MFMA_MLSTM
#if USE_MFMA_ATTN
            if (INK(2) && IN(b0 + 2)) { FRAME(); ph_attn_mfma(F, l); __syncthreads(); ph_mlstm_dc(F, l); ph_conv(F, l); if (DUP == 2) { xcd_barrier(bar); ph_attn_mfma(F, l); } if (DUP == 12) { xcd_barrier(bar); ph_mlstm_dc(F, l); } for (int rep = 0; rep < (DUP == 22 ? 1 : 0); ++rep) { xcd_barrier(bar); ph_conv(F, l); } SEAM(b0 + 2); }
#else
            if (INK(2) && IN(b0 + 2)) { FRAME(); ph_mlstm_dc(F, l); ph_attn_naive(F, l); ph_conv(F, l); SEAM(b0 + 2); }
#endif
            if (INK(3) && IN(b0 + 3)) { FRAME(); ph_mlstm_scan(F); if (DUP == 3) { xcd_barrier(bar); ph_mlstm_scan(F); } SEAM(b0 + 3); }
            if (INK(4) && IN(b0 + 4)) { FRAME(); ph_mlstm_out(F, l); if (DUP == 4) { xcd_barrier(bar); ph_mlstm_out(F, l); } SEAM(b0 + 4); }
#else
            if (INK(3) && IN(b0 + 3)) { FRAME(); ph_mlstm_naive(F, l); ph_attn_naive(F, l); ph_conv(F, l); SEAM(b0 + 3); }
            if (INK(4) && IN(b0 + 4)) { FRAME(); ph_mlstm_final(F, l); SEAM(b0 + 4); }
#endif
#if USE_MFMA_MERGE
            if (INK(5) && IN(b0 + 5)) { FRAME(); ph_merge_mfma(F, l); if (l == 0 && g >= 1 && g + 1 < NG && (int)blockIdx.x >= R / 256 * 4 && F.G > R / 256 * 4) ph_norm1_input(F, g + 1, ((int)blockIdx.x - R / 256 * 4) * NWAVES + F.wave, (F.G - R / 256 * 4) * NWAVES); if (l == 0 && g == 0 && (int)blockIdx.x >= R / 256 * 4 && F.G > R / 256 * 4) ph_convert_weights(F, CONV_P0, CONV_SPLIT, ((int)blockIdx.x - R / 256 * 4) * NWAVES + F.wave, (F.G - R / 256 * 4) * NWAVES); SEAM(b0 + 5); }
#else
            if (INK(5) && IN(b0 + 5)) { FRAME(); ph_merge_naive(F, l); SEAM(b0 + 5); }
#endif
#if USE_MFMA_WOUT
            if (INK(6) && IN(b0 + 6)) { FRAME(); ph_wout_mfma(F, g, l); if (l == 0 && g == 0 && (int)blockIdx.x >= R / 256 * 4 && F.G > R / 256 * 4) ph_convert_weights(F, CONV_SPLIT, 2 * I_LAYER, ((int)blockIdx.x - R / 256 * 4) * NWAVES + F.wave, (F.G - R / 256 * 4) * NWAVES); SEAM(b0 + 6); }
#else
            if (INK(6) && IN(b0 + 6)) { FRAME(); ph_wout_naive(F, g, l); SEAM(b0 + 6); }
#endif
            if (INK(7) && IN(b0 + 7)) { FRAME(); ph_norm2_route(F, g, l); SEAM(b0 + 7); }
#if USE_MFMA_MOE
            if (INK(9) && IN(b0 + 9)) { FRAME(); for (int rep = 0; rep < (DUP == 9 ? 2 : 1); ++rep) { if (rep) xcd_barrier(bar); ph_moe1_mfma(F, g, l); } SEAM(b0 + 9); }
            if (INK(10) && IN(b0 + 10)) { FRAME(); ph_moe2_mfma(F, g, l); if (DUP == 10) { xcd_barrier(bar); ph_moe2_mfma(F, g, l); } if (DUP == 100) { xcd_barrier(bar); xcd_barrier(bar); xcd_barrier(bar); xcd_barrier(bar); } SEAM(b0 + 10); }
#else
            if (INK(9) && IN(b0 + 9)) { FRAME(); ph_moe1_naive(F, l); SEAM(b0 + 9); }
            if (INK(10) && IN(b0 + 10)) { FRAME(); ph_moe2_naive(F, l); SEAM(b0 + 10); }
#endif
            if (INK(11) && IN(b0 + 11)) { FRAME(); ph_combine(F, g, l); if (l == DEPTH - 1 && g + 1 < NG && (g == 0 || F.G <= R / 256 * 4)) ph_norm1_input(F, g + 1, F.gwave, F.nwave); SEAM(b0 + 11); }
            }
        }
        { constexpr int l = 1;
            const int b0 = 1 + (g * DEPTH + l) * NPH;
            if (!(b0 + NPH <= lo || b0 >= hi)) {
            if (INK(0) && IN(b0 + 0)) { if (l == 0 && g == 0) { FRAME(); ph_norm1_input(F, g, F.gwave, F.nwave); SEAM(b0 + 0); } }
#if USE_MFMA_WIN
            if (INK(1) && IN(b0 + 1)) { FRAME(); ph_win_mfma(F, l); if (DUP == 1) { xcd_barrier(bar); ph_win_mfma(F, l); } SEAM(b0 + 1); }
#else
            if (INK(1) && IN(b0 + 1)) { FRAME(); ph_win_naive(F, l); SEAM(b0 + 1); }
            if (INK(2) && IN(b0 + 2)) { FRAME(); ph_rope(F); SEAM(b0 + 2); }
#endif
#if USE_MFMA_MLSTM
#if USE_MFMA_ATTN
            if (INK(2) && IN(b0 + 2)) { FRAME(); ph_attn_mfma(F, l); __syncthreads(); ph_mlstm_dc(F, l); ph_conv(F, l); if (DUP == 2) { xcd_barrier(bar); ph_attn_mfma(F, l); } if (DUP == 12) { xcd_barrier(bar); ph_mlstm_dc(F, l); } for (int rep = 0; rep < (DUP == 22 ? 1 : 0); ++rep) { xcd_barrier(bar); ph_conv(F, l); } SEAM(b0 + 2); }
#else
            if (INK(2) && IN(b0 + 2)) { FRAME(); ph_mlstm_dc(F, l); ph_attn_naive(F, l); ph_conv(F, l); SEAM(b0 + 2); }
#endif
            if (INK(3) && IN(b0 + 3)) { FRAME(); ph_mlstm_scan(F); if (DUP == 3) { xcd_barrier(bar); ph_mlstm_scan(F); } SEAM(b0 + 3); }
            if (INK(4) && IN(b0 + 4)) { FRAME(); ph_mlstm_out(F, l); if (DUP == 4) { xcd_barrier(bar); ph_mlstm_out(F, l); } SEAM(b0 + 4); }
#else
            if (INK(3) && IN(b0 + 3)) { FRAME(); ph_mlstm_naive(F, l); ph_attn_naive(F, l); ph_conv(F, l); SEAM(b0 + 3); }
            if (INK(4) && IN(b0 + 4)) { FRAME(); ph_mlstm_final(F, l); SEAM(b0 + 4); }
#endif
#if USE_MFMA_MERGE
            if (INK(5) && IN(b0 + 5)) { FRAME(); ph_merge_mfma(F, l); if (l == 0 && g >= 1 && g + 1 < NG && (int)blockIdx.x >= R / 256 * 4 && F.G > R / 256 * 4) ph_norm1_input(F, g + 1, ((int)blockIdx.x - R / 256 * 4) * NWAVES + F.wave, (F.G - R / 256 * 4) * NWAVES); if (l == 0 && g == 0 && (int)blockIdx.x >= R / 256 * 4 && F.G > R / 256 * 4) ph_convert_weights(F, CONV_P0, CONV_SPLIT, ((int)blockIdx.x - R / 256 * 4) * NWAVES + F.wave, (F.G - R / 256 * 4) * NWAVES); SEAM(b0 + 5); }
#else
            if (INK(5) && IN(b0 + 5)) { FRAME(); ph_merge_naive(F, l); SEAM(b0 + 5); }
#endif
#if USE_MFMA_WOUT
            if (INK(6) && IN(b0 + 6)) { FRAME(); ph_wout_mfma(F, g, l); if (l == 0 && g == 0 && (int)blockIdx.x >= R / 256 * 4 && F.G > R / 256 * 4) ph_convert_weights(F, CONV_SPLIT, 2 * I_LAYER, ((int)blockIdx.x - R / 256 * 4) * NWAVES + F.wave, (F.G - R / 256 * 4) * NWAVES); SEAM(b0 + 6); }
#else
            if (INK(6) && IN(b0 + 6)) { FRAME(); ph_wout_naive(F, g, l); SEAM(b0 + 6); }
#endif
            if (INK(7) && IN(b0 + 7)) { FRAME(); ph_norm2_route(F, g, l); SEAM(b0 + 7); }
#if USE_MFMA_MOE
            if (INK(9) && IN(b0 + 9)) { FRAME(); for (int rep = 0; rep < (DUP == 9 ? 2 : 1); ++rep) { if (rep) xcd_barrier(bar); ph_moe1_mfma(F, g, l); } SEAM(b0 + 9); }
            if (INK(10) && IN(b0 + 10)) { FRAME(); ph_moe2_mfma(F, g, l); if (DUP == 10) { xcd_barrier(bar); ph_moe2_mfma(F, g, l); } if (DUP == 100) { xcd_barrier(bar); xcd_barrier(bar); xcd_barrier(bar); xcd_barrier(bar); } SEAM(b0 + 10); }
#else
            if (INK(9) && IN(b0 + 9)) { FRAME(); ph_moe1_naive(F, l); SEAM(b0 + 9); }
            if (INK(10) && IN(b0 + 10)) { FRAME(); ph_moe2_naive(F, l); SEAM(b0 + 10); }
#endif
            if (INK(11) && IN(b0 + 11)) { FRAME(); ph_combine(F, g, l); if (l == DEPTH - 1 && g + 1 < NG && (g == 0 || F.G <= R / 256 * 4)) ph_norm1_input(F, g + 1, F.gwave, F.nwave); SEAM(b0 + 11); }
            }
        }
    }
#undef IN
#undef SEAM
}

extern "C" void kernel_launch(void* const* d_in, const int* in_sizes, int n_in, void* d_out, int out_size, void* d_ws, size_t ws_size, hipStream_t stream) {
    static int grid = 0;
    if (grid == 0) {
        if (n_in != 27 || out_size != BATCH * SEQ * D || ws_size < WS_END) { fprintf(stderr, "kernel_launch: unexpected shapes (n_in %d out %d ws %zu need %zu)\n", n_in, out_size, ws_size, (size_t)WS_END); grid = -1; return; }
        int dev = 0, cus = 0, per_cu = 0;
        if (hipGetDevice(&dev) != hipSuccess || hipDeviceGetAttribute(&cus, hipDeviceAttributeMultiprocessorCount, dev) != hipSuccess) { grid = -1; return; }
        if (hipFuncSetAttribute((const void*)mk_fwd, hipFuncAttributeMaxDynamicSharedMemorySize, LDS_BYTES) != hipSuccess) { fprintf(stderr, "kernel_launch: hipFuncSetAttribute failed\n"); grid = -1; return; }
        if (hipOccupancyMaxActiveBlocksPerMultiprocessor(&per_cu, (const void*)mk_fwd, NTHR, LDS_BYTES) != hipSuccess || per_cu < 1) { fprintf(stderr, "kernel_launch: occupancy query says %d\n", per_cu); }
        (void)hipGetLastError();
        grid = cus;
    }
    if (grid < 0) return;
    if (hipMemsetAsync((char*)d_ws + WS_CTL, 0, CTL_ZERO_BYTES, stream) != hipSuccess) return;
    Args a{};
    for (int i = 0; i < 27; ++i) a.in[i] = (const float*)d_in[i];
    a.out = (float*)d_out; a.ws = (unsigned char*)d_ws;
#if MK_ONE_LAUNCH
    a.ph_lo = 0; a.ph_hi = NPHASES;
    hipLaunchKernelGGL(mk_fwd, dim3(grid), dim3(NTHR), LDS_BYTES, stream, a);
#else
    for (int p = 0; p < NPHASES; ++p) {
        const int k = (p == 0) ? -1 : (p - 1) % NPH, l = (p == 0) ? 0 : ((p - 1) / NPH) % DEPTH;
        if ((k == 0 && l != 0) || k == 8) continue;
        a.ph_lo = p; a.ph_hi = p + 1;
        hipLaunchKernelGGL(mk_fwd, dim3(grid), dim3(NTHR), LDS_BYTES, stream, a);
    }
#endif
}
```
